# Optimizing an MI355X kernel written in HIP

```python
import math
import jax, jax.numpy as jnp
from jax import lax
import numpy as np

D_MODEL = 1024
BATCH = 8
SEQ = 2048
DEPTH = 1
DEC_BATCH = 128
DEC_SEQ = 8
PAST_LEN = 16384
PAGE_SIZE = 128

D_MIX = D_MODEL
D_GLA = D_MIX // 2
GLA_HEADS = 4
GLA_DV = D_GLA // GLA_HEADS
GLA_DK = GLA_DV // 2
GLA_KDIM = GLA_HEADS * GLA_DK
GATE_RANK = 16
GATE_NORMALIZER = 16.0
GLA_CHUNK = 64
D_CMLP = D_MIX - D_GLA
CMLP_GROUPS = 4
CMLP_G = D_CMLP // CMLP_GROUPS
CMLP_CHUNK = 128
D_FF = 4 * D_MODEL
EPS = 1e-6
PROJ_SIZES = (GLA_KDIM, GLA_KDIM, D_GLA, GATE_RANK, D_GLA, D_CMLP, D_CMLP)
PROJ_OFFSETS = tuple(int(v) for v in np.cumsum(PROJ_SIZES)[:-1])
D_PROJ = int(sum(PROJ_SIZES))

kernel_name = "hybrid_gla_chunkmlp_decode_step"


def rmsnorm(x, g):
    x32 = x.astype(jnp.float32)
    y = x32 * lax.rsqrt(jnp.mean(x32 * x32, axis=-1, keepdims=True) + EPS)
    return y.astype(x.dtype) * g


def layernorm(x, g, b):
    x32 = x.astype(jnp.float32)
    mu = jnp.mean(x32, axis=-1, keepdims=True)
    xc = x32 - mu
    y = xc * lax.rsqrt(jnp.mean(xc * xc, axis=-1, keepdims=True) + EPS)
    return y.astype(x.dtype) * g + b


def project(xn, w_in, w_gate_up, b_gate):
    B, T, _ = xn.shape
    h = xn @ w_in
    q, k, v, glr, og, u, vc = jnp.split(h, PROJ_OFFSETS, axis=-1)
    q = q.reshape(B, T, GLA_HEADS, GLA_DK) * (GLA_DK ** -0.5)
    k = k.reshape(B, T, GLA_HEADS, GLA_DK)
    v = v.reshape(B, T, GLA_HEADS, GLA_DV)
    g = jax.nn.log_sigmoid((glr @ w_gate_up + b_gate).astype(jnp.float32)) / GATE_NORMALIZER
    g = g.reshape(B, T, GLA_HEADS, GLA_DK)
    return q, k, v, g, og, u, vc


def gla_chunk(S, q, k, v, g):
    S = S.astype(jnp.float32)
    q = q.astype(jnp.float32)
    k = k.astype(jnp.float32)
    v = v.astype(jnp.float32)
    C = q.shape[1]
    b = jnp.cumsum(g, axis=1)
    causal = jnp.tril(jnp.ones((C, C), dtype=bool))
    diff = b[:, :, None] - b[:, None, :]
    decay = jnp.exp(jnp.where(causal[None, :, :, None, None], diff, -jnp.inf))
    scores = jnp.einsum('bihd,bjhd,bijhd->bhij', q, k, decay)
    o = (jnp.einsum('bhij,bjhv->bihv', scores, v)
         + jnp.einsum('bihd,bhdv->bihv', q * jnp.exp(b), S))
    b_last = b[:, -1]
    k_dec = k * jnp.exp(b_last[:, None] - b)
    S_new = jnp.exp(b_last)[..., None] * S + jnp.einsum('bjhd,bjhv->bhdv', k_dec, v)
    return S_new, o


def gla_prompt(S0, q, k, v, g):
    B, T = q.shape[:2]
    n = T // GLA_CHUNK

    def to_chunks(a):
        return a.reshape(B, n, GLA_CHUNK, *a.shape[2:]).swapaxes(0, 1)

    def step(S, xs):
        return gla_chunk(S, *xs)

    S_T, o = lax.scan(step, S0, (to_chunks(q), to_chunks(k), to_chunks(v), to_chunks(g)))
    o = o.swapaxes(0, 1).reshape(B, T, GLA_HEADS, GLA_DV)
    return S_T, o


def gla_output(o, og, gla_onorm_g, dtype):
    B, T = o.shape[:2]
    o = rmsnorm(o.astype(dtype), gla_onorm_g).reshape(B, T, D_GLA)
    return o * jax.nn.silu(og)


def chunk_mlp(u, vn, w_s, b_s, L):
    B, T = u.shape[:2]
    n = T // L
    mask = jnp.tril(jnp.ones((L, L), dtype=w_s.dtype))
    W = w_s[:, :L, :L] * mask
    vg = vn.reshape(B, n, L, CMLP_GROUPS, CMLP_G)
    s = jnp.einsum('hij,bcjhg->bcihg', W, vg) + b_s[:, :L].T[None, None, :, :, None]
    return u * s.reshape(B, T, D_CMLP)


def layer(x, S0, cm_len, norm_mix_g, w_in, w_gate_up, b_gate, gla_onorm_g, cm_ln_g, cm_ln_b,
          w_s, b_s, w_o, norm_ffn_g, w_up, w_down, norm_final_g, prompt):
    xn = rmsnorm(x, norm_mix_g)
    q, k, v, g, og, u, vc = project(xn, w_in, w_gate_up, b_gate)
    if prompt:
        S_new, o = gla_prompt(S0, q, k, v, g)
    else:
        S_new, o = gla_chunk(S0, q, k, v, g)
    y_a = gla_output(o, og, gla_onorm_g, x.dtype)
    u = jax.nn.gelu(u)
    vn = layernorm(jax.nn.gelu(vc), cm_ln_g, cm_ln_b)
    y_b = chunk_mlp(u, vn, w_s, b_s, cm_len)
    h = x + jnp.concatenate([y_a, y_b], axis=-1) @ w_o
    f = jnp.square(jax.nn.relu(rmsnorm(h, norm_ffn_g) @ w_up)) @ w_down
    h = h + f
    y = rmsnorm(h, norm_final_g)
    B, T = x.shape[:2]
    return y, S_new.astype(x.dtype), vn.reshape(B, T, CMLP_GROUPS, CMLP_G)


def setup_inputs(seed: int = 0) -> dict:
    key = jax.random.key(seed)
    ks = jax.random.split(key, 20)
    f32 = jnp.float32
    nrm = lambda k, shape, s: jax.random.normal(k, shape, f32) * s
    return {
        "x_prompt": nrm(ks[0], (BATCH, SEQ, D_MODEL), 1.0),
        "x_sample": nrm(ks[1], (DEC_BATCH, DEC_SEQ, D_MODEL), 1.0),
        "state_gla": nrm(ks[2], (DEC_BATCH, GLA_HEADS, GLA_DK, GLA_DV), 0.5),
        "norm_mix_g": 1.0 + nrm(ks[3], (D_MODEL,), 0.02),
        "w_in": nrm(ks[4], (D_MODEL, D_PROJ), D_MODEL ** -0.5),
        "w_gate_up": nrm(ks[5], (GATE_RANK, GLA_KDIM), GATE_RANK ** -0.5),
        "b_gate": nrm(ks[6], (GLA_KDIM,), 0.1),
        "gla_onorm_g": 1.0 + nrm(ks[7], (GLA_DV,), 0.02),
        "cm_ln_g": 1.0 + nrm(ks[8], (D_CMLP,), 0.02),
        "cm_ln_b": nrm(ks[9], (D_CMLP,), 0.02),
        "w_s": nrm(ks[10], (CMLP_GROUPS, CMLP_CHUNK, CMLP_CHUNK), CMLP_CHUNK ** -0.5),
        "b_s": 1.0 + nrm(ks[11], (CMLP_GROUPS, CMLP_CHUNK), 0.02),
        "w_o": nrm(ks[12], (D_MIX, D_MODEL), D_MIX ** -0.5),
        "norm_ffn_g": 1.0 + nrm(ks[13], (D_MODEL,), 0.02),
        "w_up": nrm(ks[14], (D_MODEL, D_FF), D_MODEL ** -0.5),
        "w_down": nrm(ks[15], (D_FF, D_MODEL), D_FF ** -0.5),
        "norm_final_g": 1.0 + nrm(ks[16], (D_MODEL,), 0.02),
    }


def reference(x_prompt, x_sample, state_gla, norm_mix_g, w_in, w_gate_up, b_gate, gla_onorm_g,
              cm_ln_g, cm_ln_b, w_s, b_s, w_o, norm_ffn_g, w_up, w_down, norm_final_g):
    yp, ys = x_prompt, x_sample
    Sp = jnp.zeros((BATCH, GLA_HEADS, GLA_DK, GLA_DV), x_prompt.dtype)
    Ss = state_gla
    vs = None
    for _ in range(DEPTH):
        yp, Sp, _vp = layer(yp, Sp, CMLP_CHUNK, norm_mix_g, w_in, w_gate_up, b_gate, gla_onorm_g,
                            cm_ln_g, cm_ln_b, w_s, b_s, w_o, norm_ffn_g, w_up, w_down,
                            norm_final_g, True)
        ys, Ss, vs = layer(ys, Ss, DEC_SEQ, norm_mix_g, w_in, w_gate_up, b_gate, gla_onorm_g,
                           cm_ln_g, cm_ln_b, w_s, b_s, w_o, norm_ffn_g, w_up, w_down,
                           norm_final_g, False)
    return (yp, ys, Sp, Ss, vs)
```

```cpp
#include <hip/hip_runtime.h>
#include <cstdio>
#include <cstdint>
#define MK_N_LAUNCHES 1
namespace pg8 {
#define PG8_LAS __attribute__((address_space(3)))
typedef unsigned short bf16_t;
typedef short bf16x8 __attribute__((ext_vector_type(8)));
typedef float f32x4 __attribute__((ext_vector_type(4)));
typedef unsigned u32x4 __attribute__((ext_vector_type(4)));
constexpr int BM = 256, BK = 64, HALF = 128, HTB = HALF * BK * 2  , STAGE_BYTES = 8 * HTB, NXCD = 8, WGM = 8;

__host__ __device__ __forceinline__ int lds_byte(int r, int c) { const int st = (r >> 4) * 2 + (c >> 5), rr = r & 15, cc = c & 31, ob = rr * 64 + cc * 2; return st * 1024 + (ob ^ (((ob >> 9) & 1) << 5)); }
__host__ __device__ __forceinline__ void stage_rc(int b, int& R, int& C) { const int st = b / 1024, sb = b % 1024, swz = sb ^ (((sb >> 9) & 1) << 5); R = (st >> 1) * 16 + swz / 64; C = (st & 1) * 32 + (swz % 64) / 2; }
__host__ __device__ __forceinline__ int perm32(int rho) { const int n = rho >> 4, i = rho & 15; return 8 * (i >> 2) + 4 * n + (i & 3); }

struct Unit { int pm, pn; };
struct Gemm { const bf16_t* A; const bf16_t* Bt; int M, N, K; };

struct StaticOrder {
    int nM, nN, nwg, G, c;
    __host__ __device__ void init(int M, int N, int G_, int c_) { nM = M / BM; nN = N / BM; nwg = nM * nN; G = G_; c = c_; }
    __host__ __device__ bool next(int i, Unit& u) const {
        const long L = (long)i * G + c; if (L >= nwg) return false;
        int wgid = (int)L; { const int q = nwg / NXCD, r = nwg % NXCD, xcd = wgid % NXCD, off = wgid / NXCD; wgid = (xcd < r ? xcd * (q + 1) : r * (q + 1) + (xcd - r) * q) + off; }
        const int nig = WGM * nN, gid = wgid / nig, fm = gid * WGM, gsz = (nM - fm) < WGM ? (nM - fm) : WGM;
        u.pm = fm + ((wgid % nig) % gsz); u.pn = (wgid % nig) / gsz; return true;
    }
    __device__ __forceinline__ void a_ready(const Unit&) const {}
    __device__ __forceinline__ void done(const Unit&) const {}
};


constexpr int cD = 1024, cNP = 16384, cFF = 4096, cLDP = 2560;
constexpr float cEPS = 1e-6f;
__device__ __forceinline__ unsigned cvt_pk_bf16(float lo, float hi) { unsigned r; asm volatile("v_cvt_pk_bf16_f32 %0, %1, %2" : "=v"(r) : "v"(lo), "v"(hi)); return r; }
typedef unsigned u32x2 __attribute__((ext_vector_type(2)));
__device__ __forceinline__ float gelu_tanh(float x) {
    const float t = x * (1.0f + 0.044715f * x * x);
    const float e = __builtin_amdgcn_exp2f(t * (-2.0f * 0.7978845608028654f * 1.4426950408889634f));
    return x * __builtin_amdgcn_rcpf(1.0f + e);
}
struct EpiProj {
    static constexpr bool PERM = true, AFTER_DRAIN = false;
    bf16_t* P; float* GLR;
    __device__ __forceinline__ void operator()(const f32x4 (&acc)[2][2][4][2], const Unit& u, int wr, int wc, int fr, int fq) const {
        const int row0 = u.pm * BM + wr * 64 + fr;
        if (u.pn == 10) {
            if (wc == 0 && fq < 2) {
#pragma unroll
                for (int ai = 0; ai < 2; ++ai)
#pragma unroll
                    for (int m = 0; m < 4; ++m) { float* g = GLR + (size_t)(row0 + ai * HALF + m * 16) * 16 + 8 * fq; *(f32x4*)g = acc[ai][0][m][0]; *(f32x4*)(g + 4) = acc[ai][0][m][1]; }
            }
            return;
        }
        const int mode = (u.pn == 0) ? 1 : (u.pn >= 6 ? 2 : 0);
        const int col0 = u.pn * BM + wc * 32 + 8 * fq;
#pragma unroll
        for (int ai = 0; ai < 2; ++ai)
#pragma unroll
            for (int m = 0; m < 4; ++m) { bf16_t* rowp = P + (size_t)(row0 + ai * HALF + m * 16) * cLDP + col0;
#pragma unroll
                for (int bj = 0; bj < 2; ++bj) { f32x4 v0 = acc[ai][bj][m][0], v1 = acc[ai][bj][m][1];
                    if (mode == 1) { v0 = v0 * 0.125f; v1 = v1 * 0.125f; }
                    if (mode == 2) {
#pragma unroll
                        for (int e = 0; e < 4; ++e) { v0[e] = gelu_tanh(v0[e]); v1[e] = gelu_tanh(v1[e]); } }
                    u32x4 w; w.x = cvt_pk_bf16(v0[0], v0[1]); w.y = cvt_pk_bf16(v0[2], v0[3]); w.z = cvt_pk_bf16(v1[0], v1[1]); w.w = cvt_pk_bf16(v1[2], v1[3]);
                    *(u32x4*)(rowp + bj * HALF) = w; } }
    }
};
struct EpiWo {
    static constexpr bool PERM = false, AFTER_DRAIN = false;
    const float* xp; const float* xs; float* H1; bf16_t* H1B; float* rowss;
    __device__ __forceinline__ void operator()(const f32x4 (&acc)[2][2][4][2], const Unit& u, int wr, int wc, int fr, int fq) const {
        const int row0 = u.pm * BM + wr * 64 + fr, col0 = u.pn * BM + wc * 32 + 4 * fq;
#pragma unroll
        for (int ai = 0; ai < 2; ++ai)
#pragma unroll
            for (int m = 0; m < 4; ++m) { const int row = row0 + ai * HALF + m * 16;
                const float* xr = (row < cNP ? xp + (size_t)row * cD : xs + (size_t)(row - cNP) * cD) + col0;
                float* hr = H1 + (size_t)row * cD + col0; bf16_t* hb = H1B + (size_t)row * cD + col0; float ss = 0.f;
#pragma unroll
                for (int bj = 0; bj < 2; ++bj)
#pragma unroll
                    for (int n = 0; n < 2; ++n) { const int off = bj * HALF + n * 16; const f32x4 h = *(const f32x4*)(xr + off) + acc[ai][bj][m][n];
                        *(f32x4*)(hr + off) = h; ss += (h[0] * h[0] + h[1] * h[1]) + (h[2] * h[2] + h[3] * h[3]);
                        u32x2 w; w.x = cvt_pk_bf16(h[0], h[1]); w.y = cvt_pk_bf16(h[2], h[3]); *(u32x2*)(hb + off) = w; }
                ss += __shfl_xor(ss, 16); ss += __shfl_xor(ss, 32);
                if (fq == 0) atomicAdd(rowss + row, ss);
                asm volatile("" ::: "memory"); }
    }
};
struct EpiUp {
    static constexpr bool PERM = true, AFTER_DRAIN = false;
    bf16_t* ACT; float* rowss;
    __device__ __forceinline__ void operator()(const f32x4 (&acc)[2][2][4][2], const Unit& u, int wr, int wc, int fr, int fq) const {
        const int row0 = u.pm * BM + wr * 64 + fr, col0 = u.pn * BM + wc * 32 + 8 * fq;
#pragma unroll
        for (int ai = 0; ai < 2; ++ai)
#pragma unroll
            for (int m = 0; m < 4; ++m) { const int row = row0 + ai * HALF + m * 16;
                const float r2 = __builtin_amdgcn_rcpf(rowss[row] * (1.0f / cD) + cEPS);
                bf16_t* rowp = ACT + (size_t)row * cFF + col0;
#pragma unroll
                for (int bj = 0; bj < 2; ++bj) { f32x4 v0 = acc[ai][bj][m][0], v1 = acc[ai][bj][m][1];
#pragma unroll
                    for (int e = 0; e < 4; ++e) { const float a = fmaxf(v0[e], 0.f), b = fmaxf(v1[e], 0.f); v0[e] = a * a * r2; v1[e] = b * b * r2; }
                    u32x4 w; w.x = cvt_pk_bf16(v0[0], v0[1]); w.y = cvt_pk_bf16(v0[2], v0[3]); w.z = cvt_pk_bf16(v1[0], v1[1]); w.w = cvt_pk_bf16(v1[2], v1[3]);
                    *(u32x4*)(rowp + bj * HALF) = w; } }
    }
};
struct EpiDown {
    static constexpr bool PERM = false, AFTER_DRAIN = false;
    float* H;
    __device__ __forceinline__ void operator()(const f32x4 (&acc)[2][2][4][2], const Unit& u, int wr, int wc, int fr, int fq) const {
        const int row0 = u.pm * BM + wr * 64 + fr, col0 = u.pn * BM + wc * 32 + 4 * fq;
#pragma unroll
        for (int ai = 0; ai < 2; ++ai)
#pragma unroll
            for (int m = 0; m < 4; ++m) { float* hr = H + (size_t)(row0 + ai * HALF + m * 16) * cD + col0;
#pragma unroll
                for (int bj = 0; bj < 2; ++bj)
#pragma unroll
                    for (int n = 0; n < 2; ++n) { const int off = bj * HALF + n * 16; *(f32x4*)(hr + off) = *(const f32x4*)(hr + off) + acc[ai][bj][m][n]; }
                asm volatile("" ::: "memory"); }
    }
};

template <class Epi, class Sched, bool ALIGN_EPI = false, bool SP2 = false>
__device__ __forceinline__ void gemm_phase(PG8_LAS unsigned char* lds, const Gemm g, const Sched& S, const Epi& E) {
    const int tid = threadIdx.x, wid = __builtin_amdgcn_readfirstlane(tid >> 6), lane = tid & 63, wr = wid >> 2, wc = wid & 3, fr = lane & 15, fq = lane >> 4;
    const int K = g.K, nt = K / BK;
    unsigned voffA[2], voffB[2];
#pragma unroll
    for (int i = 0; i < 2; ++i) { int R, C; stage_rc(tid * 16 + i * 8192, R, C); const int Rb = Epi::PERM ? ((R & ~31) + perm32(R & 31)) : R;
        voffA[i] = (unsigned)(R * K + C) * 2u; voffB[i] = (unsigned)(Rb * K + C) * 2u; }
    const size_t kstep = (size_t)(BK * 2);
    const size_t hstep = (size_t)HALF * K * 2;
    const size_t tstep = 2 * hstep;
    const unsigned ldsw = (unsigned)wid * 1024u;
    const int aoff = lds_byte(wr * 64 + fr, fq * 8), boff = lds_byte(wc * 32 + fr, fq * 8);
#define PG8_SA(b, h) (((b) * 2 + (h)) * HTB)
#define PG8_SB(b, h) ((4 + (b) * 2 + (h)) * HTB)
#define PG8_STAGE(bufoff, gbase, voff) do { _Pragma("unroll") for (int _i = 0; _i < 2; ++_i) \
        __builtin_amdgcn_global_load_lds((const unsigned*)((const char*)(gbase) + (voff)[_i]), (PG8_LAS unsigned*)(lds + (bufoff) + ldsw + _i * 8192), 16, 0, 0); } while (0)
#define PG8_LDA(dst, b, h) do { _Pragma("unroll") for (int m = 0; m < 4; ++m) _Pragma("unroll") for (int k = 0; k < 2; ++k) dst[m][k] = *(const PG8_LAS bf16x8*)(lds + PG8_SA(b, h) + aoff + m * 2048 + k * 1024); } while (0)
#define PG8_LDB(dst, b, h) do { _Pragma("unroll") for (int n = 0; n < 2; ++n) _Pragma("unroll") for (int k = 0; k < 2; ++k) dst[n][k] = *(const PG8_LAS bf16x8*)(lds + PG8_SB(b, h) + boff + n * 2048 + k * 1024); } while (0)
#define PG8_MMA(ai, bj, At, Bt) do { __builtin_amdgcn_s_setprio(1); _Pragma("unroll") for (int m = 0; m < 4; ++m) _Pragma("unroll") for (int n = 0; n < 2; ++n) _Pragma("unroll") for (int k = 0; k < 2; ++k) \
        acc[ai][bj][m][n] = __builtin_amdgcn_mfma_f32_16x16x32_bf16(Bt[n][k], At[m][k], acc[ai][bj][m][n], 0, 0, 0); __builtin_amdgcn_s_setprio(0); } while (0)
#define PG8_WAIT_V(n) asm volatile("s_waitcnt vmcnt(" #n ")" ::: "memory")
#define PG8_WAIT_L(n) asm volatile("s_waitcnt lgkmcnt(" #n ")" ::: "memory")
#define PG8_BAR __builtin_amdgcn_s_barrier()
#define PG8_SCHED __builtin_amdgcn_sched_barrier(0)
    Unit cur, nxt; int ui = 0;
    if (!S.next(0, cur)) return;
    f32x4 acc[2][2][4][2];
#pragma unroll
    for (int a = 0; a < 2; ++a)
#pragma unroll
        for (int b = 0; b < 2; ++b)
#pragma unroll
            for (int m = 0; m < 4; ++m)
#pragma unroll
                for (int n = 0; n < 2; ++n) acc[a][b][m][n] = (f32x4){0.f, 0.f, 0.f, 0.f};
    bf16x8 At[4][2], B0[2][2], B1[2][2];
    const char* cA = (const char*)g.A + (size_t)cur.pm * tstep; const char* cB = (const char*)g.Bt + (size_t)cur.pn * tstep;
    S.a_ready(cur);
    if constexpr (SP2) {
        PG8_STAGE(PG8_SB(0, 0), cB, voffB); PG8_STAGE(PG8_SB(0, 1), cB + hstep, voffB); PG8_STAGE(PG8_SA(0, 0), cA, voffA); PG8_STAGE(PG8_SA(0, 1), cA + hstep, voffA);
        if (wr == 1) PG8_BAR;
        PG8_WAIT_V(2); PG8_BAR;
        PG8_STAGE(PG8_SB(1, 0), cB + kstep, voffB); PG8_STAGE(PG8_SA(1, 0), cA + kstep, voffA); PG8_STAGE(PG8_SB(1, 1), cB + hstep + kstep, voffB);
        PG8_WAIT_V(6); PG8_BAR;
    } else {
        PG8_STAGE(PG8_SB(0, 0), cB, voffB); PG8_STAGE(PG8_SA(0, 0), cA, voffA); PG8_STAGE(PG8_SB(0, 1), cB + hstep, voffB); PG8_STAGE(PG8_SA(0, 1), cA + hstep, voffA);
        if (wr == 1) PG8_BAR;
        PG8_WAIT_V(4); PG8_BAR;
        PG8_STAGE(PG8_SB(1, 0), cB + kstep, voffB); PG8_STAGE(PG8_SA(1, 0), cA + kstep, voffA); PG8_STAGE(PG8_SB(1, 1), cB + hstep + kstep, voffB);
        PG8_WAIT_V(6); PG8_BAR;
    }
    for (;;) {
        const bool has_next = S.next(ui + 1, nxt);
        const char* nA = has_next ? (const char*)g.A + (size_t)nxt.pm * tstep : cA; const char* nB = has_next ? (const char*)g.Bt + (size_t)nxt.pn * tstep : cB;
        for (int t = 0; t < nt; t += 2) {
            const bool last = (t == nt - 2);
            const char* a1 = cA + (size_t)(t + 1) * kstep;
            const char* a2 = last ? nA : cA + (size_t)(t + 2) * kstep; const char* b2 = last ? nB : cB + (size_t)(t + 2) * kstep;
            const char* a3 = a2 + kstep; const char* b3 = b2 + kstep;
            if (last && has_next) S.a_ready(nxt);
            if constexpr (SP2) {
            PG8_LDB(B0, 0, 0); PG8_LDB(B1, 0, 1); PG8_SCHED; PG8_LDA(At, 0, 0); PG8_STAGE(PG8_SA(1, 1), a1 + hstep, voffA);
            PG8_WAIT_V(8); PG8_WAIT_L(0); PG8_BAR; PG8_MMA(0, 0, At, B0); PG8_MMA(0, 1, At, B1); PG8_BAR; PG8_SCHED;
            PG8_LDA(At, 0, 1); PG8_STAGE(PG8_SB(0, 0), b2, voffB); PG8_STAGE(PG8_SB(0, 1), b2 + hstep, voffB); PG8_STAGE(PG8_SA(0, 0), a2, voffA);
            PG8_WAIT_V(8); PG8_WAIT_L(0); PG8_BAR; PG8_MMA(1, 0, At, B0); PG8_MMA(1, 1, At, B1); PG8_BAR; PG8_SCHED;
            PG8_LDB(B0, 1, 0); PG8_LDB(B1, 1, 1); PG8_SCHED; PG8_LDA(At, 1, 0); PG8_STAGE(PG8_SA(0, 1), a2 + hstep, voffA);
            PG8_WAIT_V(8); PG8_WAIT_L(0); PG8_BAR; PG8_MMA(0, 0, At, B0); PG8_MMA(0, 1, At, B1); PG8_BAR; PG8_SCHED;
            PG8_LDA(At, 1, 1); PG8_STAGE(PG8_SB(1, 0), b3, voffB); PG8_STAGE(PG8_SB(1, 1), b3 + hstep, voffB); PG8_STAGE(PG8_SA(1, 0), a3, voffA);
            PG8_WAIT_V(8); PG8_WAIT_L(0); PG8_BAR; PG8_MMA(1, 0, At, B0); PG8_MMA(1, 1, At, B1); PG8_BAR; PG8_SCHED;
            } else {
            PG8_LDB(B0, 0, 0); PG8_SCHED; PG8_LDA(At, 0, 0); PG8_STAGE(PG8_SA(1, 1), a1 + hstep, voffA);
            PG8_WAIT_L(8); PG8_BAR; PG8_WAIT_L(0); PG8_MMA(0, 0, At, B0); PG8_BAR; PG8_SCHED;
            PG8_LDB(B1, 0, 1); PG8_STAGE(PG8_SB(0, 0), b2, voffB);
            PG8_BAR; PG8_WAIT_L(0); PG8_MMA(0, 1, At, B1); PG8_BAR;
            PG8_LDA(At, 0, 1); PG8_STAGE(PG8_SA(0, 0), a2, voffA);
            PG8_BAR; PG8_WAIT_L(0); PG8_MMA(1, 0, At, B0); PG8_BAR; PG8_SCHED;
            PG8_STAGE(PG8_SB(0, 1), b2 + hstep, voffB);
            PG8_WAIT_V(6); PG8_BAR; PG8_MMA(1, 1, At, B1); PG8_BAR;
            PG8_LDB(B0, 1, 0); PG8_SCHED; PG8_LDA(At, 1, 0); PG8_STAGE(PG8_SA(0, 1), a2 + hstep, voffA);
            PG8_WAIT_L(8); PG8_BAR; PG8_WAIT_L(0); PG8_MMA(0, 0, At, B0); PG8_BAR; PG8_SCHED;
            PG8_LDB(B1, 1, 1); PG8_STAGE(PG8_SB(1, 0), b3, voffB);
            PG8_BAR; PG8_WAIT_L(0); PG8_MMA(0, 1, At, B1); PG8_BAR;
            PG8_LDA(At, 1, 1); PG8_STAGE(PG8_SA(1, 0), a3, voffA);
            PG8_BAR; PG8_WAIT_L(0); PG8_MMA(1, 0, At, B0); PG8_BAR; PG8_SCHED;
            PG8_STAGE(PG8_SB(1, 1), b3 + hstep, voffB);
            PG8_WAIT_V(6); PG8_BAR; PG8_MMA(1, 1, At, B1); PG8_BAR;
            }
        }
        if constexpr (ALIGN_EPI) { if (wr == 0) PG8_BAR; }
        if constexpr (!Epi::AFTER_DRAIN) { E(acc, cur, wr, wc, fr, fq); S.done(cur); }
        if (!has_next) break;
#pragma unroll
        for (int a = 0; a < 2; ++a)
#pragma unroll
            for (int b = 0; b < 2; ++b)
#pragma unroll
                for (int m = 0; m < 4; ++m)
#pragma unroll
                    for (int n = 0; n < 2; ++n) acc[a][b][m][n] = (f32x4){0.f, 0.f, 0.f, 0.f};
        cur = nxt; cA = nA; cB = nB; ++ui;
        if constexpr (ALIGN_EPI) { if (wr == 1) PG8_BAR; }
    }
    PG8_WAIT_V(0);
    if constexpr (!ALIGN_EPI) { if (wr == 0) PG8_BAR; }
    PG8_BAR;
    if constexpr (Epi::AFTER_DRAIN) { E.fused(acc, cur, wr, wc, fr, fq, lds, wid, lane); S.done(cur); }
#undef PG8_SA
#undef PG8_SB
#undef PG8_STAGE
#undef PG8_LDA
#undef PG8_LDB
#undef PG8_MMA
#undef PG8_WAIT_V
#undef PG8_WAIT_L
#undef PG8_BAR
#undef PG8_SCHED
}
}
#ifndef PG8_SP2
#define PG8_SP2 true
#endif
#ifndef PG8_ALIGN
#define PG8_ALIGN true
#endif
constexpr int NWAVES = 8;
#ifndef MK_N_LAUNCHES
#define MK_N_LAUNCHES 1
#endif
constexpr int PER_PHASE = 9;
constexpr int N_LAUNCHES = MK_N_LAUNCHES;

constexpr int D = 1024, NP = 16384, NS = 1024, M = NP + NS, FF = 4096, NPROJ = 2816, LDP = 2560;
constexpr int SEQ = 2048, NB = 8, NH = 4, DK = 64, DV = 128, NCH = SEQ / 64, DECB = 128, DECS = 8;
constexpr int PQ = 0, PK = 256, PV = 512, POG = 1024, PU = 1536, PVC = 2048;
constexpr float EPS = 1e-6f;
constexpr int NITEM_GLA = NB * NH * NCH;
constexpr size_t OUT_Y = 0, OUT_SP = (size_t)M * D, OUT_SS = OUT_SP + (size_t)NB * NH * DK * DV, OUT_VS = OUT_SS + (size_t)DECB * NH * DK * DV;

constexpr size_t MiB = 1u << 20;
constexpr size_t WS_CTL = 0, CTL_ZERO_BYTES = 256 * 1024;
constexpr size_t WS_RSS = 128 * 1024;
constexpr size_t WS_WIN = 2 * MiB, WS_WO = 8 * MiB, WS_WUP = 10 * MiB, WS_WDN = 18 * MiB;
constexpr size_t WS_GLR = 26 * MiB;
constexpr size_t WS_DEC = 28 * MiB;
constexpr size_t WS_XN = 30 * MiB;
constexpr size_t WS_PROJ = 64 * MiB;
constexpr size_t WS_U = 149 * MiB;
constexpr size_t WS_MIX = 181 * MiB;
constexpr size_t WS_ACT = 64 * MiB;
constexpr size_t WS_END = 215 * MiB;
static_assert(WS_PROJ + (size_t)M * LDP * 2 <= WS_U && WS_U + (size_t)NITEM_GLA * DK * DV * 4 <= WS_MIX && WS_MIX + (size_t)M * D * 2 <= WS_END && WS_ACT + (size_t)M * FF * 2 <= WS_END && WS_XN + (size_t)M * D * 2 <= WS_PROJ, "d_ws map");
static_assert(WS_GLR + (size_t)M * 16 * 4 <= WS_DEC && WS_DEC + (size_t)NITEM_GLA * 64 * 4 <= WS_XN && WS_WIN + (size_t)NPROJ * D * 2 <= WS_WO && WS_RSS + (size_t)M * 4 <= CTL_ZERO_BYTES, "d_ws map 2");
constexpr int CW_TMO = 0, CW_CODE = 1;
constexpr int CW_BAR = 4096;

constexpr int RING_OFF = 0, RING_BYTES = 131072;
constexpr int LDSCTL_OFF = RING_BYTES, MISC_OFF = LDSCTL_OFF + 320;
constexpr int LDS_BYTES = 147456;
static_assert(MISC_OFF + 128 <= LDS_BYTES, "LDS map");

#define GAS __attribute__((address_space(1)))
#define LAS __attribute__((address_space(3)))
typedef unsigned short bf16;
typedef unsigned v4u __attribute__((ext_vector_type(4)));
typedef unsigned v2u __attribute__((ext_vector_type(2)));
typedef float f32x4 __attribute__((ext_vector_type(4)));
typedef float f32x2 __attribute__((ext_vector_type(2)));
typedef short bf16x8 __attribute__((ext_vector_type(8)));
typedef GAS unsigned gu32;
typedef GAS unsigned long long gu64;
#define RLX_AGENT __ATOMIC_RELAXED, __HIP_MEMORY_SCOPE_AGENT
#define LDS_WAIT() asm volatile("s_waitcnt lgkmcnt(0)" ::: "memory")
#define VM_WAIT() asm volatile("s_waitcnt vmcnt(0)" ::: "memory")
__device__ __forceinline__ unsigned f2bf(float f) { unsigned u = __builtin_bit_cast(unsigned, f); return (u + 0x7fffu + ((u >> 16) & 1u)) >> 16; }
__device__ __forceinline__ unsigned pk2(float lo, float hi) { return f2bf(lo) | (f2bf(hi) << 16); }
__device__ __forceinline__ float bf2f(unsigned b) { return __builtin_bit_cast(float, b << 16); }
__device__ __forceinline__ float bflo(unsigned w) { return __builtin_bit_cast(float, w << 16); }
__device__ __forceinline__ float bfhi(unsigned w) { return __builtin_bit_cast(float, w & 0xffff0000u); }

#define XB_TMO      128
#define XB_XCNT(j)  (256  + 64 * (j))
#define XB_XSUB(j)  (1280 + 64 * (j))
#define XB_XGEN(j)  (2304 + 64 * (j))
#define XB_TOP      3328
#define XB_TOPGEN   3392
#define XCD_BAR_WORDS 3456
#define XB_SPIN_CAP (1u << 18)

__device__ __forceinline__ unsigned xb_ld(unsigned* p)              { return __hip_atomic_load(p, __ATOMIC_RELAXED, __HIP_MEMORY_SCOPE_AGENT); }
__device__ __forceinline__ unsigned xb_add(unsigned* p, unsigned v) { return __hip_atomic_fetch_add(p, v, __ATOMIC_RELAXED, __HIP_MEMORY_SCOPE_AGENT); }
__device__ __forceinline__ unsigned xb_xcc_id() { return (unsigned)__builtin_amdgcn_s_getreg((3 << 11) | 20) & 0xFu; }
#define XB_SPIN(cond, bar) do { unsigned _sp = 0; while (cond) { __builtin_amdgcn_s_sleep(1); \
    if ((++_sp & 255u) == 0u) { if (xb_ld(&(bar)[XB_TMO])) break; if (_sp > XB_SPIN_CAP) { atomicAdd(&(bar)[XB_TMO], 1u); break; } } } } while (0)

struct XcdBarrier {
    unsigned* bar; unsigned x;
    volatile LAS unsigned* st;
};

__device__ __forceinline__ XcdBarrier xcd_barrier_post(unsigned* bar, volatile LAS unsigned* st) {
    XcdBarrier b; b.bar = bar; b.x = xb_xcc_id(); b.st = st;
    if (threadIdx.x == 0) (void)xb_add(&bar[XB_XCNT(b.x)], 1u);
    return b;
}
__device__ __forceinline__ void xcd_barrier_complete(unsigned* bar, unsigned x, unsigned& nloc, unsigned& nx) {
    const unsigned G = gridDim.x * gridDim.y * gridDim.z;
    unsigned sum, cnt, mine, sp = 0u;
    for (;;) {
        sum = 0u; cnt = 0u; mine = 0u;
#pragma unroll
        for (unsigned j = 0; j < 16; ++j) { const unsigned c = xb_ld(&bar[XB_XCNT(j)]); sum += c; cnt += (c > 0u) ? 1u : 0u; mine = (j == x) ? c : mine; }
        if (sum == G) break;
        __builtin_amdgcn_s_sleep(1);
        if ((++sp & 255u) == 0u) { if (xb_ld(&bar[XB_TMO])) break; if (sp > XB_SPIN_CAP) { atomicAdd(&bar[XB_TMO], 1u); break; } }
    }
    nloc = mine > 0u ? mine : 1u; nx = cnt > 0u ? cnt : 1u;
}

__device__ __forceinline__ void xcd_barrier(const XcdBarrier& b) {
    asm volatile("s_waitcnt vmcnt(0)" ::: "memory");
    __syncthreads();
    if (threadIdx.x == 0) {
        unsigned* bar = b.bar;
        __builtin_amdgcn_s_waitcnt(0);
        unsigned nloc = b.st[0], nx = b.st[1];
        if (nloc == 0u) { xcd_barrier_complete(bar, b.x, nloc, nx); b.st[0] = nloc; b.st[1] = nx; }
        const unsigned old = xb_add(&bar[XB_XSUB(b.x)], 1u);
        const unsigned gen = old / nloc;
        if (old + 1u == (gen + 1u) * nloc) {
            __builtin_amdgcn_fence(__ATOMIC_RELEASE, "agent");
            asm volatile("s_waitcnt vmcnt(0)" ::: "memory");
            const unsigned og = xb_add(&bar[XB_TOP], 1u);
            const unsigned tg = og / nx;
            if (og + 1u == (tg + 1u) * nx) xb_add(&bar[XB_TOPGEN], 1u);
            else XB_SPIN(xb_ld(&bar[XB_TOPGEN]) == tg, bar);
            __builtin_amdgcn_fence(__ATOMIC_ACQUIRE, "agent");
            xb_add(&bar[XB_XGEN(b.x)], 1u);
            asm volatile("s_waitcnt vmcnt(0)" ::: "memory");
        } else {
            XB_SPIN(xb_ld(&bar[XB_XGEN(b.x)]) == gen, bar);
            __builtin_amdgcn_fence(__ATOMIC_ACQUIRE, "agent");
            asm volatile("s_waitcnt vmcnt(0)" ::: "memory");
        }
    }
    __syncthreads();
}

struct Frame {
    LAS unsigned char* lds;
    volatile LAS unsigned* MISC;
    gu32* ctl;
    int tid, lane, wave;
    int vcu, G;
    const float *xp, *xs, *state, *g_mix, *w_in, *w_gu, *b_gate, *g_on, *ln_g, *ln_b, *w_s, *b_s, *w_o, *g_ffn, *w_up, *w_dn, *g_fin;
    float* out;
    bf16 *WinT, *WoT, *WupT, *WdnT, *XN, *PROJ, *MIX, *ACT;
    float *GLR, *DEC, *U, *RSS;
};

__device__ __forceinline__ float wave_sum(float v) {
#pragma unroll
    for (int o = 1; o < 64; o <<= 1) v += __shfl_xor(v, o);
    return v;
}
__device__ __forceinline__ float logsig(float z) { return fminf(z, 0.f) - __logf(1.f + __expf(-fabsf(z))); }
__device__ __forceinline__ float silu(float x) { return x * __builtin_amdgcn_rcpf(1.f + __expf(-x)); }
__device__ __forceinline__ bf16x8 ldfrag(const LAS bf16* X, int LD, int r0, int k0, int lane) { return *(const LAS bf16x8*)(X + (r0 + (lane & 15)) * LD + k0 + 8 * (lane >> 4)); }
__device__ __forceinline__ bf16x8 frag_gather(const LAS bf16* X, int LD, int k0, int c0, int lane) {
    const LAS bf16* p = X + (k0 + 8 * (lane >> 4)) * LD + c0 + (lane & 15);
    bf16x8 r;
#pragma unroll
    for (int j = 0; j < 8; ++j) r[j] = (short)p[j * LD];
    return r;
}
#define MFMA16(a, b, c) __builtin_amdgcn_mfma_f32_16x16x32_bf16((a), (b), (c), 0, 0, 0)

__device__ __forceinline__ void p0_transpose_item(const float* W, int K, int Nsrc, bf16* WT, const float* gk, int mode, LAS float* scr, int kb, int nb, int lane) {
    const int k0 = 64 * kb, n0 = 32 * nb, n = n0 + (lane & 31);
    int src = n;
    if (mode == 1) src = n < 1024 ? n : (n < 2560 ? n + 16 : (n < 2576 ? n - 1536 : -1));
#pragma unroll 8
    for (int i = 0; i < 32; ++i) { const int kk = 2 * i + (lane >> 5); float v = 0.f;
        if (src >= 0) { v = W[(size_t)(k0 + kk) * Nsrc + src]; if (gk) v *= gk[k0 + kk]; }
        scr[kk * 33 + (lane & 31)] = v; }
    LDS_WAIT(); asm volatile("" ::: "memory");
    const int c = lane & 7;
#pragma unroll
    for (int j = 0; j < 4; ++j) { const int nn = (lane >> 3) + 8 * j; const LAS float* s = scr + (8 * c) * 33 + nn;
        v4u o; o.x = pk2(s[0 * 33], s[1 * 33]); o.y = pk2(s[2 * 33], s[3 * 33]); o.z = pk2(s[4 * 33], s[5 * 33]); o.w = pk2(s[6 * 33], s[7 * 33]);
        *(GAS v4u*)(WT + (size_t)(n0 + nn) * K + k0 + 8 * c) = o; }
    LDS_WAIT(); asm volatile("" ::: "memory");
}
__device__ __forceinline__ void rms_row_to_bf16(const float* xrow, bf16* orow, int lane) {
    const GAS f32x4* xr = (const GAS f32x4*)xrow + lane;
    f32x4 v[4]; float s = 0.f;
#pragma unroll
    for (int j = 0; j < 4; ++j) { v[j] = xr[64 * j]; s += (v[j].x * v[j].x + v[j].y * v[j].y) + (v[j].z * v[j].z + v[j].w * v[j].w); }
    const float rstd = 1.f / sqrtf(wave_sum(s) * (1.f / D) + EPS);
    GAS unsigned long long* o8 = (GAS unsigned long long*)orow + lane;
#pragma unroll
    for (int j = 0; j < 4; ++j) o8[64 * j] = (unsigned long long)pk2(v[j].x * rstd, v[j].y * rstd) | ((unsigned long long)pk2(v[j].z * rstd, v[j].w * rstd) << 32);
}
__device__ __forceinline__ void p0_prologue(Frame& F) {
    LAS float* scr = (LAS float*)(F.lds + RING_OFF + F.wave * 16384);
    const int gw = F.vcu * NWAVES + F.wave, NGW = F.G * NWAVES;
    constexpr int I_IN = (D / 64) * (NPROJ / 32), I_O = (D / 64) * (D / 32), I_UP = (D / 64) * (FF / 32), I_DN = (FF / 64) * (D / 32);
    constexpr int NITEMS = I_IN + I_O + I_UP + I_DN;
    for (int it = gw; it < NITEMS; it += NGW) {
        int r = it;
        if (r < I_IN) { p0_transpose_item(F.w_in, D, 2576, F.WinT, F.g_mix, 1, scr, r / (NPROJ / 32), r % (NPROJ / 32), F.lane); continue; } r -= I_IN;
        if (r < I_O) { p0_transpose_item(F.w_o, D, D, F.WoT, nullptr, 0, scr, r / (D / 32), r % (D / 32), F.lane); continue; } r -= I_O;
        if (r < I_UP) { p0_transpose_item(F.w_up, D, FF, F.WupT, F.g_ffn, 0, scr, r / (FF / 32), r % (FF / 32), F.lane); continue; } r -= I_UP;
        p0_transpose_item(F.w_dn, FF, D, F.WdnT, nullptr, 0, scr, r / (D / 32), r % (D / 32), F.lane);
    }
    for (int m = gw; m < M; m += NGW) rms_row_to_bf16(m < NP ? F.xp + (size_t)m * D : F.xs + (size_t)(m - NP) * D, F.XN + (size_t)m * D, F.lane);
}

#define GLA_LOAD_GATEW() float wg[16]; _Pragma("unroll") for (int r = 0; r < 16; ++r) wg[r] = F.w_gu[r * 256 + h * 64 + d]; const float bg = F.b_gate[h * 64 + d]

__device__ __forceinline__ void gla_local_item(Frame& F, int id) {
    const int bh = id >> 5, c = id & 31, b = bh >> 2, h = bh & 3, r0 = b * SEQ + c * 64;
    LAS unsigned char* L = F.lds;
    LAS float* glr_s = (LAS float*)L;
    LAS float* wtot = (LAS float*)(L + 4096);
    LAS bf16* kdT = (LAS bf16*)(L + 6144);
    LAS bf16* Vs = (LAS bf16*)(L + 15360);
    const int tid = F.tid, lane = F.lane, w = F.wave, d = lane, fr = lane & 15, fq = lane >> 4;
    if (tid < 256) ((LAS f32x4*)glr_s)[tid] = ((const GAS f32x4*)(F.GLR + (size_t)r0 * 16))[tid];
    { const int t = tid >> 3, sg = (tid & 7) * 16; const GAS v4u* src = (const GAS v4u*)(F.PROJ + (size_t)(r0 + t) * LDP + PV + h * DV + sg);
      const v4u a = src[0], bq = src[1]; LAS v4u* dst = (LAS v4u*)(Vs + t * 136 + sg); dst[0] = a; dst[1] = bq; }
    float kv[8];
#pragma unroll
    for (int tt = 0; tt < 8; ++tt) kv[tt] = bf2f(((const GAS bf16*)F.PROJ)[(size_t)(r0 + 8 * w + tt) * LDP + PK + h * DK + d]);
    GLA_LOAD_GATEW();
    __syncthreads();
    float cs[8], run = 0.f;
#pragma unroll
    for (int tt = 0; tt < 8; ++tt) { const LAS float* gl = glr_s + (8 * w + tt) * 16; float z = bg;
#pragma unroll
        for (int r = 0; r < 16; ++r) z += gl[r] * wg[r];
        run += logsig(z) * (1.f / 16.f); cs[tt] = run; }
    wtot[w * 64 + d] = run;
    __syncthreads();
    float off = 0.f, tot = 0.f;
#pragma unroll
    for (int w2 = 0; w2 < 8; ++w2) { const float x = wtot[w2 * 64 + d]; tot += x; if (w2 < w) off += x; }
    { v4u pk;
      pk.x = pk2(kv[0] * __expf(tot - off - cs[0]), kv[1] * __expf(tot - off - cs[1])); pk.y = pk2(kv[2] * __expf(tot - off - cs[2]), kv[3] * __expf(tot - off - cs[3]));
      pk.z = pk2(kv[4] * __expf(tot - off - cs[4]), kv[5] * __expf(tot - off - cs[5])); pk.w = pk2(kv[6] * __expf(tot - off - cs[6]), kv[7] * __expf(tot - off - cs[7]));
      *(LAS v4u*)(kdT + d * 72 + 8 * w) = pk; }
    if (w == 0) ((GAS float*)F.DEC)[(size_t)id * 64 + d] = __expf(tot);
    __syncthreads();
    f32x4 acc[4];
#pragma unroll
    for (int q = 0; q < 4; ++q) acc[q] = (f32x4){0.f, 0.f, 0.f, 0.f};
#pragma unroll
    for (int ks = 0; ks < 2; ++ks) { const bf16x8 xa = frag_gather(Vs, 136, 32 * ks, 16 * w, lane);
#pragma unroll
        for (int db = 0; db < 4; ++db) { const bf16x8 xb = ldfrag(kdT, 72, 16 * db, 32 * ks, lane); acc[db] = MFMA16(xa, xb, acc[db]); } }
    GAS float* Uo = (GAS float*)F.U + (size_t)id * 8192;
#pragma unroll
    for (int db = 0; db < 4; ++db) *(GAS f32x4*)(Uo + (16 * db + fr) * 128 + 16 * w + 4 * fq) = acc[db];
    __syncthreads();
}

__device__ __forceinline__ void gla_sample_item(Frame& F, int it) {
    const int b = it >> 2, h = it & 3, r0 = NP + b * DECS;
    LAS unsigned char* L = F.lds;
    LAS float* S0s = (LAS float*)L;
    LAS float* glr_s = (LAS float*)(L + 32768);
    LAS float* gs = (LAS float*)(L + 33280);
    LAS float* qs = (LAS float*)(L + 35328);
    LAS float* ks = (LAS float*)(L + 37376);
    LAS float* kds = (LAS float*)(L + 39424);
    LAS float* dec_s = (LAS float*)(L + 41472);
    LAS float* vs_ = (LAS float*)(L + 41728);
    LAS float* Ps = (LAS float*)(L + 45824);
    LAS float* os = (LAS float*)(L + 46080);
    const int tid = F.tid, lane = F.lane, w = F.wave, d = lane, t = w;
    { const GAS f32x4* s0 = (const GAS f32x4*)(F.state + (size_t)it * 8192);
#pragma unroll
      for (int k = 0; k < 4; ++k) ((LAS f32x4*)S0s)[tid + 512 * k] = s0[tid + 512 * k]; }
    if (tid < 32) ((LAS f32x4*)glr_s)[tid] = ((const GAS f32x4*)(F.GLR + (size_t)r0 * 16))[tid];
    { const int tv = tid >> 6, dv2 = (tid & 63) * 2; const unsigned wv = *(const GAS unsigned*)(F.PROJ + (size_t)(r0 + tv) * LDP + PV + h * DV + dv2); vs_[tv * 128 + dv2] = bflo(wv); vs_[tv * 128 + dv2 + 1] = bfhi(wv); }
    const float qv = bf2f(((const GAS bf16*)F.PROJ)[(size_t)(r0 + t) * LDP + PQ + h * DK + d]), kv = bf2f(((const GAS bf16*)F.PROJ)[(size_t)(r0 + t) * LDP + PK + h * DK + d]);
    GLA_LOAD_GATEW();
    __syncthreads();
    { float z = bg;
#pragma unroll
      for (int r = 0; r < 16; ++r) z += glr_s[t * 16 + r] * wg[r];
      gs[t * 64 + d] = logsig(z) * (1.f / 16.f); }
    __syncthreads();
    { float bt = 0.f, tot = 0.f;
#pragma unroll
      for (int t2 = 0; t2 < 8; ++t2) { const float x = gs[t2 * 64 + d]; tot += x; if (t2 <= t) bt += x; }
      qs[t * 64 + d] = qv * __expf(bt); ks[t * 64 + d] = kv * __expf(-bt); kds[t * 64 + d] = kv * __expf(tot - bt); if (t == 0) dec_s[d] = __expf(tot); }
    __syncthreads();
    { const int pair = tid >> 3, part = tid & 7, i = pair >> 3, j = pair & 7; float s = 0.f;
#pragma unroll
      for (int dd = 0; dd < 8; ++dd) s += qs[i * 64 + part * 8 + dd] * ks[j * 64 + part * 8 + dd];
      s += __shfl_xor(s, 1); s += __shfl_xor(s, 2); s += __shfl_xor(s, 4);
      if (part == 0) Ps[i * 8 + j] = (j <= i) ? s : 0.f; }
    __syncthreads();
    { const int dv = tid & 127, i0 = 2 * (tid >> 7), i1 = i0 + 1; float o0 = 0.f, o1 = 0.f;
#pragma unroll 8
      for (int dd = 0; dd < 64; ++dd) { const float s = S0s[dd * 128 + dv]; o0 += qs[i0 * 64 + dd] * s; o1 += qs[i1 * 64 + dd] * s; }
#pragma unroll
      for (int j = 0; j < 8; ++j) { const float v = vs_[j * 128 + dv]; o0 += Ps[i0 * 8 + j] * v; o1 += Ps[i1 * 8 + j] * v; }
      os[i0 * 128 + dv] = o0; os[i1 * 128 + dv] = o1; }
    { const int dv4 = tid & 31, dg = tid >> 5; GAS float* So = (GAS float*)F.out + OUT_SS + (size_t)it * 8192;
#pragma unroll
      for (int q = 0; q < 4; ++q) { const int dd = dg * 4 + q; f32x4 s = ((LAS f32x4*)S0s)[dd * 32 + dv4] * dec_s[dd];
#pragma unroll
          for (int j = 0; j < 8; ++j) s += ((LAS f32x4*)vs_)[j * 32 + dv4] * kds[j * 64 + dd];
          *(GAS f32x4*)(So + dd * 128 + 4 * dv4) = s; } }
    __syncthreads();
    { const int i = w; const float o0 = os[i * 128 + 2 * lane], o1 = os[i * 128 + 2 * lane + 1];
      const float rstd = 1.f / sqrtf(wave_sum(o0 * o0 + o1 * o1) * (1.f / DV) + EPS);
      const unsigned ogw = *(const GAS unsigned*)(F.PROJ + (size_t)(r0 + i) * LDP + POG + h * DV + 2 * lane);
      const float y0 = o0 * rstd * F.g_on[2 * lane] * silu(bflo(ogw)), y1 = o1 * rstd * F.g_on[2 * lane + 1] * silu(bfhi(ogw));
      *(GAS unsigned*)(F.MIX + (size_t)(r0 + i) * D + h * DV + 2 * lane) = pk2(y0, y1); }
    __syncthreads();
}

__device__ __forceinline__ void cmlp_sample_item(Frame& F, int b) {
    const int r0 = NP + b * DECS;
    LAS float* vn_s = (LAS float*)F.lds;
    const int tid = F.tid, lane = F.lane, w = F.wave;
    { const int i = w; const v4u raw = *(const GAS v4u*)(F.PROJ + (size_t)(r0 + i) * LDP + PVC + 8 * lane);
      float x[8] = {bflo(raw.x), bfhi(raw.x), bflo(raw.y), bfhi(raw.y), bflo(raw.z), bfhi(raw.z), bflo(raw.w), bfhi(raw.w)};
      float s = 0.f;
#pragma unroll
      for (int e = 0; e < 8; ++e) s += x[e];
      const float mean = wave_sum(s) * (1.f / 512.f); float q = 0.f;
#pragma unroll
      for (int e = 0; e < 8; ++e) { x[e] -= mean; q += x[e] * x[e]; }
      const float rstd = 1.f / sqrtf(wave_sum(q) * (1.f / 512.f) + EPS);
      f32x4 o0, o1;
#pragma unroll
      for (int e = 0; e < 8; ++e) { const float y = x[e] * rstd * F.ln_g[8 * lane + e] + F.ln_b[8 * lane + e]; vn_s[i * 512 + 8 * lane + e] = y; if (e < 4) o0[e] = y; else o1[e - 4] = y; }
      GAS f32x4* vo = (GAS f32x4*)((GAS float*)F.out + OUT_VS + (size_t)(b * DECS + i) * 512 + 8 * lane); vo[0] = o0; vo[1] = o1; }
    __syncthreads();
    { const int ch = tid, h = ch >> 7;
#pragma unroll
      for (int i = 0; i < 8; ++i) { float s = F.b_s[h * 128 + i];
#pragma unroll
          for (int j = 0; j <= i; ++j) s += F.w_s[h * 16384 + i * 128 + j] * vn_s[j * 512 + ch];
          const float ug = bf2f(((const GAS bf16*)F.PROJ)[(size_t)(r0 + i) * LDP + PU + ch]);
          ((GAS bf16*)F.MIX)[(size_t)(r0 + i) * D + 512 + ch] = (bf16)f2bf(ug * s); } }
    __syncthreads();
}

__device__ __forceinline__ void gla_scan(Frame& F) {
    for (int gid = F.vcu * 512 + F.tid; gid < 32 * 4096; gid += F.G * 512) {
        const int bh = gid >> 12, e2 = gid & 4095, dk = e2 >> 6;
        GAS f32x2* Up = (GAS f32x2*)((GAS float*)F.U + (size_t)bh * 32 * 8192) + e2; const GAS float* Dp = (const GAS float*)F.DEC + (size_t)bh * 32 * 64 + dk;
        f32x2 S = (f32x2){0.f, 0.f};
        for (int c0 = 0; c0 < 32; c0 += 8) { f32x2 u[8]; float dc[8];
#pragma unroll
            for (int k = 0; k < 8; ++k) { u[k] = Up[(size_t)(c0 + k) * 4096]; dc[k] = Dp[(c0 + k) * 64]; }
#pragma unroll
            for (int k = 0; k < 8; ++k) { Up[(size_t)(c0 + k) * 4096] = S; S = S * dc[k] + u[k]; } }
        *(GAS f32x2*)((GAS float*)F.out + OUT_SP + (size_t)bh * 8192 + 2 * e2) = S;
    }
}

__device__ __forceinline__ void cmlp_prompt_item(Frame& F, int it) {
    const int b = it >> 5, chk = (it >> 1) & 15, gp = it & 1, r0 = b * SEQ + chk * 128;
    LAS unsigned char* L = F.lds;
    LAS float* stats = (LAS float*)L;
    LAS bf16* Wm = (LAS bf16*)(L + 1024);
    LAS bf16* vns = (LAS bf16*)(L + 1024 + 34816);
    const int tid = F.tid, lane = F.lane, w = F.wave, fr = lane & 15, fq = lane >> 4;
    for (int q = 0; q < 16; ++q) { const int t = 16 * w + q; const v4u raw = *(const GAS v4u*)(F.PROJ + (size_t)(r0 + t) * LDP + PVC + 8 * lane);
        float x[8] = {bflo(raw.x), bfhi(raw.x), bflo(raw.y), bfhi(raw.y), bflo(raw.z), bfhi(raw.z), bflo(raw.w), bfhi(raw.w)};
        float s = 0.f;
#pragma unroll
        for (int e = 0; e < 8; ++e) s += x[e];
        const float mean = wave_sum(s) * (1.f / 512.f); float qq = 0.f;
#pragma unroll
        for (int e = 0; e < 8; ++e) { x[e] -= mean; qq += x[e] * x[e]; }
        const float rstd = 1.f / sqrtf(wave_sum(qq) * (1.f / 512.f) + EPS);
        if (lane == 0) { stats[2 * t] = mean; stats[2 * t + 1] = rstd; } }
    __syncthreads();
    for (int g2 = 0; g2 < 2; ++g2) { const int h = 2 * gp + g2;
        { const int i = tid >> 2, js = (tid & 3) * 32; const GAS f32x4* wp = (const GAS f32x4*)(F.w_s + (size_t)h * 16384 + i * 128 + js);
#pragma unroll
          for (int q = 0; q < 4; ++q) { f32x4 a = wp[2 * q], cc = wp[2 * q + 1]; const int j0 = js + 8 * q;
#pragma unroll
              for (int e = 0; e < 4; ++e) { if (j0 + e > i) a[e] = 0.f; if (j0 + 4 + e > i) cc[e] = 0.f; }
              v4u o; o.x = pk2(a[0], a[1]); o.y = pk2(a[2], a[3]); o.z = pk2(cc[0], cc[1]); o.w = pk2(cc[2], cc[3]); *(LAS v4u*)(Wm + i * 136 + j0) = o; } }
        { const int t = tid >> 2, cs = (tid & 3) * 32; const float mean = stats[2 * t], rstd = stats[2 * t + 1]; const GAS v4u* vp = (const GAS v4u*)(F.PROJ + (size_t)(r0 + t) * LDP + PVC + h * 128 + cs);
#pragma unroll
          for (int q = 0; q < 4; ++q) { const v4u raw = vp[q]; const int c0 = h * 128 + cs + 8 * q;
              float x[8] = {bflo(raw.x), bfhi(raw.x), bflo(raw.y), bfhi(raw.y), bflo(raw.z), bfhi(raw.z), bflo(raw.w), bfhi(raw.w)};
#pragma unroll
              for (int e = 0; e < 8; ++e) x[e] = (x[e] - mean) * rstd * F.ln_g[c0 + e] + F.ln_b[c0 + e];
              v4u o; o.x = pk2(x[0], x[1]); o.y = pk2(x[2], x[3]); o.z = pk2(x[4], x[5]); o.w = pk2(x[6], x[7]); *(LAS v4u*)(vns + t * 136 + cs + 8 * q) = o; } }
        __syncthreads();
        f32x4 acc[8];
#pragma unroll
        for (int q = 0; q < 8; ++q) acc[q] = (f32x4){0.f, 0.f, 0.f, 0.f};
#pragma unroll
        for (int ks = 0; ks < 4; ++ks) { const bf16x8 xa = frag_gather(vns, 136, 32 * ks, 16 * w, lane);
#pragma unroll
            for (int ib = 0; ib < 8; ++ib) if (ib >= 2 * ks) { const bf16x8 xb = ldfrag(Wm, 136, 16 * ib, 32 * ks, lane); acc[ib] = MFMA16(xa, xb, acc[ib]); } }
#pragma unroll
        for (int ib = 0; ib < 8; ++ib) { const int i = 16 * ib + fr, chn = h * 128 + 16 * w + 4 * fq; const float bs = F.b_s[h * 128 + i];
            const v2u uw = *(const GAS v2u*)(F.PROJ + (size_t)(r0 + i) * LDP + PU + chn);
            v2u o; o.x = pk2(bflo(uw.x) * (acc[ib][0] + bs), bfhi(uw.x) * (acc[ib][1] + bs)); o.y = pk2(bflo(uw.y) * (acc[ib][2] + bs), bfhi(uw.y) * (acc[ib][3] + bs));
            *(GAS v2u*)(F.MIX + (size_t)(r0 + i) * D + 512 + chn) = o; }
        __syncthreads();
    }
}

__device__ __forceinline__ void gla_out_item(Frame& F, int id) {
    const int bh = id >> 5, c = id & 31, b = bh >> 2, h = bh & 3, r0 = b * SEQ + c * 64;
    LAS unsigned char* L = F.lds;
    LAS float* glr_s = (LAS float*)L;
    LAS float* wtot = (LAS float*)(L + 4096);
    LAS bf16* qt = (LAS bf16*)(L + 6144);
    LAS bf16* kt = (LAS bf16*)(L + 15360);
    LAS bf16* Pm = (LAS bf16*)(L + 24576);
    LAS bf16* Vs = (LAS bf16*)(L + 33792);
    LAS bf16* SB = (LAS bf16*)(L + 51200);
    LAS float* os = (LAS float*)(L + 68608);
    const int tid = F.tid, lane = F.lane, w = F.wave, d = lane, fr = lane & 15, fq = lane >> 4;
    if (tid < 256) ((LAS f32x4*)glr_s)[tid] = ((const GAS f32x4*)(F.GLR + (size_t)r0 * 16))[tid];
    { const int t = tid >> 3, sg = (tid & 7) * 16; const GAS v4u* src = (const GAS v4u*)(F.PROJ + (size_t)(r0 + t) * LDP + PV + h * DV + sg);
      const v4u a = src[0], bq = src[1]; LAS v4u* dst = (LAS v4u*)(Vs + t * 136 + sg); dst[0] = a; dst[1] = bq; }
    { const int dkk = tid >> 3, sg = (tid & 7) * 16; const GAS f32x4* sp = (const GAS f32x4*)((GAS float*)F.U + (size_t)id * 8192 + dkk * 128 + sg);
      const f32x4 a0 = sp[0], a1 = sp[1], a2 = sp[2], a3 = sp[3]; v4u o0, o1;
      o0.x = pk2(a0[0], a0[1]); o0.y = pk2(a0[2], a0[3]); o0.z = pk2(a1[0], a1[1]); o0.w = pk2(a1[2], a1[3]);
      o1.x = pk2(a2[0], a2[1]); o1.y = pk2(a2[2], a2[3]); o1.z = pk2(a3[0], a3[1]); o1.w = pk2(a3[2], a3[3]);
      LAS v4u* dst = (LAS v4u*)(SB + dkk * 136 + sg); dst[0] = o0; dst[1] = o1; }
    float qv[8], kv[8];
#pragma unroll
    for (int tt = 0; tt < 8; ++tt) { const GAS bf16* pr = (const GAS bf16*)F.PROJ + (size_t)(r0 + 8 * w + tt) * LDP + h * DK + d; qv[tt] = bf2f(pr[PQ]); kv[tt] = bf2f(pr[PK]); }
    GLA_LOAD_GATEW();
    __syncthreads();
    float cs[8], run = 0.f;
#pragma unroll
    for (int tt = 0; tt < 8; ++tt) { const LAS float* gl = glr_s + (8 * w + tt) * 16; float z = bg;
#pragma unroll
        for (int r = 0; r < 16; ++r) z += gl[r] * wg[r];
        run += logsig(z) * (1.f / 16.f); cs[tt] = run; }
    wtot[w * 64 + d] = run;
    __syncthreads();
    float off = 0.f;
#pragma unroll
    for (int w2 = 0; w2 < 8; ++w2) { const float x = wtot[w2 * 64 + d]; if (w2 < w) off += x; }
#pragma unroll
    for (int tt = 0; tt < 8; ++tt) { const float bt = off + cs[tt]; qt[(8 * w + tt) * 72 + d] = (bf16)f2bf(qv[tt] * __expf(bt)); kt[(8 * w + tt) * 72 + d] = (bf16)f2bf(kv[tt] * __expf(-bt)); }
    __syncthreads();
    { const int jb = w & 3, ih = w >> 2; f32x4 a2[2]; a2[0] = (f32x4){0.f, 0.f, 0.f, 0.f}; a2[1] = a2[0];
#pragma unroll
      for (int ks = 0; ks < 2; ++ks) { const bf16x8 xa = ldfrag(kt, 72, 16 * jb, 32 * ks, lane);
#pragma unroll
          for (int q = 0; q < 2; ++q) { const bf16x8 xb = ldfrag(qt, 72, 16 * (2 * ih + q), 32 * ks, lane); a2[q] = MFMA16(xa, xb, a2[q]); } }
#pragma unroll
      for (int q = 0; q < 2; ++q) { const int i = 16 * (2 * ih + q) + fr, j0 = 16 * jb + 4 * fq;
          const float v0 = (j0 <= i) ? a2[q][0] : 0.f, v1 = (j0 + 1 <= i) ? a2[q][1] : 0.f, v2 = (j0 + 2 <= i) ? a2[q][2] : 0.f, v3 = (j0 + 3 <= i) ? a2[q][3] : 0.f;
          v2u o; o.x = pk2(v0, v1); o.y = pk2(v2, v3); *(LAS v2u*)(Pm + i * 72 + j0) = o; } }
    __syncthreads();
    { const int ib = w & 3, dvh = w >> 2; f32x4 a4[4];
#pragma unroll
      for (int n = 0; n < 4; ++n) a4[n] = (f32x4){0.f, 0.f, 0.f, 0.f};
#pragma unroll
      for (int ks = 0; ks < 2; ++ks) { const bf16x8 xb = ldfrag(Pm, 72, 16 * ib, 32 * ks, lane);
#pragma unroll
          for (int n = 0; n < 4; ++n) { const bf16x8 xa = frag_gather(Vs, 136, 32 * ks, 16 * (4 * dvh + n), lane); a4[n] = MFMA16(xa, xb, a4[n]); } }
#pragma unroll
      for (int ks = 0; ks < 2; ++ks) { const bf16x8 xb = ldfrag(qt, 72, 16 * ib, 32 * ks, lane);
#pragma unroll
          for (int n = 0; n < 4; ++n) { const bf16x8 xa = frag_gather(SB, 136, 32 * ks, 16 * (4 * dvh + n), lane); a4[n] = MFMA16(xa, xb, a4[n]); } }
#pragma unroll
      for (int n = 0; n < 4; ++n) *(LAS f32x4*)(os + (16 * ib + fr) * 132 + 16 * (4 * dvh + n) + 4 * fq) = a4[n]; }
    __syncthreads();
    { const int t = tid >> 3, sg = (tid & 7) * 16; const LAS f32x4* op = (const LAS f32x4*)(os + t * 132 + sg);
      f32x4 o[4]; float ss = 0.f;
#pragma unroll
      for (int q = 0; q < 4; ++q) { o[q] = op[q]; ss += (o[q][0] * o[q][0] + o[q][1] * o[q][1]) + (o[q][2] * o[q][2] + o[q][3] * o[q][3]); }
      ss += __shfl_xor(ss, 1); ss += __shfl_xor(ss, 2); ss += __shfl_xor(ss, 4);
      const float rstd = 1.f / sqrtf(ss * (1.f / DV) + EPS);
      const GAS v4u* ogp = (const GAS v4u*)(F.PROJ + (size_t)(r0 + t) * LDP + POG + h * DV + sg); const v4u g0 = ogp[0], g1 = ogp[1];
      const unsigned gw_[8] = {g0.x, g0.y, g0.z, g0.w, g1.x, g1.y, g1.z, g1.w}; unsigned ow[8];
#pragma unroll
      for (int p = 0; p < 8; ++p) { const int e = 2 * p; const float y0 = o[e >> 2][e & 3] * rstd * F.g_on[sg + e] * silu(bflo(gw_[p])), y1 = o[(e + 1) >> 2][(e + 1) & 3] * rstd * F.g_on[sg + e + 1] * silu(bfhi(gw_[p])); ow[p] = pk2(y0, y1); }
      GAS v4u* mo = (GAS v4u*)(F.MIX + (size_t)(r0 + t) * D + h * DV + sg); mo[0] = (v4u){ow[0], ow[1], ow[2], ow[3]}; mo[1] = (v4u){ow[4], ow[5], ow[6], ow[7]}; }
    __syncthreads();
}

__device__ __forceinline__ void final_norm(Frame& F) {
    const int gw = F.vcu * NWAVES + F.wave, NGW = F.G * NWAVES;
    f32x4 gv[4];
#pragma unroll
    for (int j = 0; j < 4; ++j) gv[j] = ((const GAS f32x4*)F.g_fin)[F.lane + 64 * j];
    for (int m = gw; m < M; m += NGW) { GAS f32x4* xr = (GAS f32x4*)((GAS float*)F.out + OUT_Y + (size_t)m * D) + F.lane;
        f32x4 v[4]; float s = 0.f;
#pragma unroll
        for (int j = 0; j < 4; ++j) { v[j] = xr[64 * j]; s += (v[j].x * v[j].x + v[j].y * v[j].y) + (v[j].z * v[j].z + v[j].w * v[j].w); }
        const float rstd = 1.f / sqrtf(wave_sum(s) * (1.f / D) + EPS);
#pragma unroll
        for (int j = 0; j < 4; ++j) xr[64 * j] = v[j] * rstd * gv[j]; }
}

struct Args { const float* in[17]; float* out; unsigned char* ws; int ph_lo, ph_hi; };
__global__ void __launch_bounds__(NWAVES * 64, 2) mega_fwd(Args args) {
    extern __shared__ __attribute__((aligned(16))) unsigned char lds[];
    Frame F;
    F.lds = (LAS unsigned char*)lds;
    F.MISC = (volatile LAS unsigned*)(F.lds + MISC_OFF);
    F.tid = threadIdx.x; F.lane = F.tid & 63; F.wave = __builtin_amdgcn_readfirstlane(F.tid >> 6);
    F.G = gridDim.x; { const int bx = blockIdx.x; F.vcu = (F.G % 8 == 0) ? (bx % 8) * (F.G / 8) + bx / 8 : bx; }
    unsigned char* ws = args.ws;
    F.ctl = (gu32*)(ws + WS_CTL);
    F.xp = args.in[0]; F.xs = args.in[1]; F.state = args.in[2]; F.g_mix = args.in[3]; F.w_in = args.in[4]; F.w_gu = args.in[5]; F.b_gate = args.in[6]; F.g_on = args.in[7];
    F.ln_g = args.in[8]; F.ln_b = args.in[9]; F.w_s = args.in[10]; F.b_s = args.in[11]; F.w_o = args.in[12]; F.g_ffn = args.in[13]; F.w_up = args.in[14]; F.w_dn = args.in[15]; F.g_fin = args.in[16];
    F.out = args.out;
    F.WinT = (bf16*)(ws + WS_WIN); F.WoT = (bf16*)(ws + WS_WO); F.WupT = (bf16*)(ws + WS_WUP); F.WdnT = (bf16*)(ws + WS_WDN);
    F.XN = (bf16*)(ws + WS_XN); F.PROJ = (bf16*)(ws + WS_PROJ); F.MIX = (bf16*)(ws + WS_MIX); F.ACT = (bf16*)(ws + WS_ACT);
    F.GLR = (float*)(ws + WS_GLR); F.DEC = (float*)(ws + WS_DEC); F.U = (float*)(ws + WS_U); F.RSS = (float*)(ws + WS_RSS);
    for (int u = F.tid; u < (LDS_BYTES - LDSCTL_OFF) / 4; u += NWAVES * 64) ((LAS unsigned*)(F.lds + LDSCTL_OFF))[u] = 0u;
    __syncthreads();
    XcdBarrier bar; bar.bar = (unsigned*)(F.ctl + CW_BAR); bar.x = 0; bar.st = nullptr;
    if (N_LAUNCHES != PER_PHASE) bar = xcd_barrier_post((unsigned*)(F.ctl + CW_BAR), F.MISC + 8);
#define GRID_BAR(seam) do { if (N_LAUNCHES == PER_PHASE) { if (F.tid == 0) __hip_atomic_store(F.ctl + CW_TMO, 0xBADBA0u | (unsigned)(seam), RLX_AGENT); } else { xcd_barrier(bar); } } while (0)
    const int lo = args.ph_lo, hi = args.ph_hi;
#define IN(k) (lo <= (k) && (k) < hi)
#define BOTH(k) (IN(k) && IN((k) + 1))

    if (IN(0)) { p0_prologue(F); if (BOTH(0)) GRID_BAR(0); }
    if (IN(1)) {
        pg8::Gemm g{F.XN, F.WinT, M, NPROJ, D}; pg8::StaticOrder S; S.init(M, NPROJ, F.G, (int)blockIdx.x);
        pg8::EpiProj E{F.PROJ, F.GLR};
        pg8::gemm_phase<pg8::EpiProj, pg8::StaticOrder, PG8_ALIGN, PG8_SP2>(F.lds + RING_OFF, g, S, E);
        if (BOTH(1)) GRID_BAR(1);
    }
    if (IN(2)) {
        for (int it = F.vcu; it < NITEM_GLA; it += F.G) gla_local_item(F, it);
        for (int it = F.vcu; it < DECB * NH; it += F.G) gla_sample_item(F, it);
        for (int it = F.vcu; it < DECB; it += F.G) cmlp_sample_item(F, it);
        if (BOTH(2)) GRID_BAR(2);
    }
    if (IN(3)) {
        gla_scan(F);
        for (int it = F.vcu; it < NB * 16 * 2; it += F.G) cmlp_prompt_item(F, it);
        if (BOTH(3)) GRID_BAR(3);
    }
    if (IN(4)) {
        for (int it = F.vcu; it < NITEM_GLA; it += F.G) gla_out_item(F, it);
        if (BOTH(4)) GRID_BAR(4);
    }
    if (IN(5)) {
        pg8::Gemm g{F.MIX, F.WoT, M, D, D}; pg8::StaticOrder S; S.init(M, D, F.G, (int)blockIdx.x);
        pg8::EpiWo E{F.xp, F.xs, F.out + OUT_Y, F.XN, F.RSS};
        pg8::gemm_phase<pg8::EpiWo, pg8::StaticOrder, PG8_ALIGN, PG8_SP2>(F.lds + RING_OFF, g, S, E);
        if (BOTH(5)) GRID_BAR(5);
    }
    if (IN(6)) {
        pg8::Gemm g{F.XN, F.WupT, M, FF, D}; pg8::StaticOrder S; S.init(M, FF, F.G, (int)blockIdx.x);
        pg8::EpiUp E{F.ACT, F.RSS};
        pg8::gemm_phase<pg8::EpiUp, pg8::StaticOrder, PG8_ALIGN, PG8_SP2>(F.lds + RING_OFF, g, S, E);
        if (BOTH(6)) GRID_BAR(6);
    }
    if (IN(7)) {
        pg8::Gemm g{F.ACT, F.WdnT, M, D, FF}; pg8::StaticOrder S; S.init(M, D, F.G, (int)blockIdx.x);
        pg8::EpiDown E{F.out + OUT_Y};
        pg8::gemm_phase<pg8::EpiDown, pg8::StaticOrder, PG8_ALIGN, PG8_SP2>(F.lds + RING_OFF, g, S, E);
        if (BOTH(7)) GRID_BAR(7);
    }
    if (IN(8)) final_norm(F);
#undef IN
#undef BOTH
}

extern "C" void kernel_launch(void* const* d_in, const int* in_sizes, int n_in, void* d_out, int out_size, void* d_ws, size_t ws_size, hipStream_t stream) {
    static int grid = 0;
    if (grid == 0) {
        if (n_in != 17 || ws_size < WS_END) { fprintf(stderr, "kernel_launch: built for 17 inputs and >= %zu bytes of workspace; got n_in %d, ws %zu; nothing launched\n", (size_t)WS_END, n_in, ws_size); grid = -1; return; }
        int dev = 0, cus = 0, per_cu = 0;
        if (hipGetDevice(&dev) != hipSuccess || hipDeviceGetAttribute(&cus, hipDeviceAttributeMultiprocessorCount, dev) != hipSuccess) { fprintf(stderr, "kernel_launch: hipGetDevice / hipDeviceGetAttribute failed\n"); grid = -1; return; }
        if (hipFuncSetAttribute((const void*)mega_fwd, hipFuncAttributeMaxDynamicSharedMemorySize, LDS_BYTES) != hipSuccess) { fprintf(stderr, "kernel_launch: hipFuncSetAttribute failed\n"); grid = -1; return; }
        if (hipOccupancyMaxActiveBlocksPerMultiprocessor(&per_cu, (const void*)mega_fwd, NWAVES * 64, LDS_BYTES) != hipSuccess || per_cu < 1)
            fprintf(stderr, "kernel_launch: note: occupancy query reports %d workgroups per CU\n", per_cu);
        (void)hipGetLastError();
        grid = cus;
    }
    if (grid < 0) return;
    if (hipMemsetAsync((char*)d_ws + WS_CTL, 0, CTL_ZERO_BYTES, stream) != hipSuccess) { fprintf(stderr, "kernel_launch: hipMemsetAsync failed\n"); return; }
    Args a{};
    for (int i = 0; i < 17; ++i) a.in[i] = (const float*)d_in[i];
    a.out = (float*)d_out; a.ws = (unsigned char*)d_ws;
    for (int li = 0; li < N_LAUNCHES; ++li) {
        a.ph_lo = (N_LAUNCHES == PER_PHASE) ? li : 0; a.ph_hi = (N_LAUNCHES == PER_PHASE) ? li + 1 : PER_PHASE;
        hipLaunchKernelGGL(mega_fwd, dim3(grid), dim3(NWAVES * 64), LDS_BYTES, stream, a);
        const hipError_t le = hipPeekAtLastError();
        if (le != hipSuccess) { fprintf(stderr, "kernel_launch: launch %d failed: %s\n", li, hipGetErrorName(le)); break; }
    }
}
```

```cpp
#include <hip/hip_runtime.h>
#include <cstdio>
#include <cstdint>
#define MK_N_LAUNCHES 1
#define PROBE_REP -1
namespace pg8 {
#define PG8_LAS __attribute__((address_space(3)))
typedef unsigned short bf16_t;
typedef short bf16x8 __attribute__((ext_vector_type(8)));
typedef float f32x4 __attribute__((ext_vector_type(4)));
typedef unsigned u32x4 __attribute__((ext_vector_type(4)));
constexpr int BM = 256, BK = 64, HALF = 128, HTB = HALF * BK * 2  , STAGE_BYTES = 8 * HTB, NXCD = 8, WGM = 8;

__host__ __device__ __forceinline__ int lds_byte(int r, int c) { const int st = (r >> 4) * 2 + (c >> 5), rr = r & 15, cc = c & 31, ob = rr * 64 + cc * 2; return st * 1024 + (ob ^ (((ob >> 9) & 1) << 5)); }
__host__ __device__ __forceinline__ void stage_rc(int b, int& R, int& C) { const int st = b / 1024, sb = b % 1024, swz = sb ^ (((sb >> 9) & 1) << 5); R = (st >> 1) * 16 + swz / 64; C = (st & 1) * 32 + (swz % 64) / 2; }
__host__ __device__ __forceinline__ int perm32(int rho) { const int n = rho >> 4, i = rho & 15; return 8 * (i >> 2) + 4 * n + (i & 3); }

struct Unit { int pm, pn; };
struct Gemm { const bf16_t* A; const bf16_t* Bt; int M, N, K; };

struct StaticOrder {
    int nM, nN, nwg, G, c;
    __host__ __device__ void init(int M, int N, int G_, int c_) { nM = M / BM; nN = N / BM; nwg = nM * nN; G = G_; c = c_; }
    __host__ __device__ bool next(int i, Unit& u) const {
        const long L = (long)i * G + c; if (L >= nwg) return false;
        int wgid = (int)L; { const int q = nwg / NXCD, r = nwg % NXCD, xcd = wgid % NXCD, off = wgid / NXCD; wgid = (xcd < r ? xcd * (q + 1) : r * (q + 1) + (xcd - r) * q) + off; }
        const int nig = WGM * nN, gid = wgid / nig, fm = gid * WGM, gsz = (nM - fm) < WGM ? (nM - fm) : WGM;
        u.pm = fm + ((wgid % nig) % gsz); u.pn = (wgid % nig) / gsz; return true;
    }
    __device__ __forceinline__ void a_ready(const Unit&) const {}
    __device__ __forceinline__ void done(const Unit&) const {}
};


constexpr int cD = 1024, cNP = 16384, cFF = 4096, cLDP = 2560;
constexpr float cEPS = 1e-6f;
__device__ __forceinline__ unsigned cvt_pk_bf16(float lo, float hi) { unsigned r; asm volatile("v_cvt_pk_bf16_f32 %0, %1, %2" : "=v"(r) : "v"(lo), "v"(hi)); return r; }
typedef unsigned u32x2 __attribute__((ext_vector_type(2)));
__device__ __forceinline__ float gelu_tanh(float x) {
    const float t = x * (1.0f + 0.044715f * x * x);
    const float e = __builtin_amdgcn_exp2f(t * (-2.0f * 0.7978845608028654f * 1.4426950408889634f));
    return x * __builtin_amdgcn_rcpf(1.0f + e);
}
struct EpiProj {
    static constexpr bool PERM = true, AFTER_DRAIN = false;
    bf16_t* P; float* GLR;
    __device__ __forceinline__ void operator()(const f32x4 (&acc)[2][2][4][2], const Unit& u, int wr, int wc, int fr, int fq) const {
        const int row0 = u.pm * BM + wr * 64 + fr;
        if (u.pn == 10) {
            if (wc == 0 && fq < 2) {
#pragma unroll
                for (int ai = 0; ai < 2; ++ai)
#pragma unroll
                    for (int m = 0; m < 4; ++m) { float* g = GLR + (size_t)(row0 + ai * HALF + m * 16) * 16 + 8 * fq; *(f32x4*)g = acc[ai][0][m][0]; *(f32x4*)(g + 4) = acc[ai][0][m][1]; }
            }
            return;
        }
        const int mode = (u.pn == 0) ? 1 : (u.pn >= 6 ? 2 : 0);
        const int col0 = u.pn * BM + wc * 32 + 8 * fq;
#pragma unroll
        for (int ai = 0; ai < 2; ++ai)
#pragma unroll
            for (int m = 0; m < 4; ++m) { bf16_t* rowp = P + (size_t)(row0 + ai * HALF + m * 16) * cLDP + col0;
#pragma unroll
                for (int bj = 0; bj < 2; ++bj) { f32x4 v0 = acc[ai][bj][m][0], v1 = acc[ai][bj][m][1];
                    if (mode == 1) { v0 = v0 * 0.125f; v1 = v1 * 0.125f; }
                    if (mode == 2) {
#pragma unroll
                        for (int e = 0; e < 4; ++e) { v0[e] = gelu_tanh(v0[e]); v1[e] = gelu_tanh(v1[e]); } }
                    u32x4 w; w.x = cvt_pk_bf16(v0[0], v0[1]); w.y = cvt_pk_bf16(v0[2], v0[3]); w.z = cvt_pk_bf16(v1[0], v1[1]); w.w = cvt_pk_bf16(v1[2], v1[3]);
                    *(u32x4*)(rowp + bj * HALF) = w; } }
    }
};
struct EpiWo {
    static constexpr bool PERM = false, AFTER_DRAIN = false;
    const float* xp; const float* xs; float* H1; bf16_t* H1B; float* rowss;
    __device__ __forceinline__ void operator()(const f32x4 (&acc)[2][2][4][2], const Unit& u, int wr, int wc, int fr, int fq) const {
        const int row0 = u.pm * BM + wr * 64 + fr, col0 = u.pn * BM + wc * 32 + 4 * fq;
#pragma unroll
        for (int ai = 0; ai < 2; ++ai)
#pragma unroll
            for (int m = 0; m < 4; ++m) { const int row = row0 + ai * HALF + m * 16;
                const float* xr = (row < cNP ? xp + (size_t)row * cD : xs + (size_t)(row - cNP) * cD) + col0;
                float* hr = H1 + (size_t)row * cD + col0; bf16_t* hb = H1B + (size_t)row * cD + col0; float ss = 0.f;
#pragma unroll
                for (int bj = 0; bj < 2; ++bj)
#pragma unroll
                    for (int n = 0; n < 2; ++n) { const int off = bj * HALF + n * 16; const f32x4 h = *(const f32x4*)(xr + off) + acc[ai][bj][m][n];
                        *(f32x4*)(hr + off) = h; ss += (h[0] * h[0] + h[1] * h[1]) + (h[2] * h[2] + h[3] * h[3]);
                        u32x2 w; w.x = cvt_pk_bf16(h[0], h[1]); w.y = cvt_pk_bf16(h[2], h[3]); *(u32x2*)(hb + off) = w; }
                ss += __shfl_xor(ss, 16); ss += __shfl_xor(ss, 32);
                if (fq == 0) atomicAdd(rowss + row, ss);
                asm volatile("" ::: "memory"); }
    }
};
struct EpiUp {
    static constexpr bool PERM = true, AFTER_DRAIN = false;
    bf16_t* ACT; float* rowss;
    __device__ __forceinline__ void operator()(const f32x4 (&acc)[2][2][4][2], const Unit& u, int wr, int wc, int fr, int fq) const {
        const int row0 = u.pm * BM + wr * 64 + fr, col0 = u.pn * BM + wc * 32 + 8 * fq;
#pragma unroll
        for (int ai = 0; ai < 2; ++ai)
#pragma unroll
            for (int m = 0; m < 4; ++m) { const int row = row0 + ai * HALF + m * 16;
                const float r2 = __builtin_amdgcn_rcpf(rowss[row] * (1.0f / cD) + cEPS);
                bf16_t* rowp = ACT + (size_t)row * cFF + col0;
#pragma unroll
                for (int bj = 0; bj < 2; ++bj) { f32x4 v0 = acc[ai][bj][m][0], v1 = acc[ai][bj][m][1];
#pragma unroll
                    for (int e = 0; e < 4; ++e) { const float a = fmaxf(v0[e], 0.f), b = fmaxf(v1[e], 0.f); v0[e] = a * a * r2; v1[e] = b * b * r2; }
                    u32x4 w; w.x = cvt_pk_bf16(v0[0], v0[1]); w.y = cvt_pk_bf16(v0[2], v0[3]); w.z = cvt_pk_bf16(v1[0], v1[1]); w.w = cvt_pk_bf16(v1[2], v1[3]);
                    *(u32x4*)(rowp + bj * HALF) = w; } }
    }
};
struct EpiDown {
    static constexpr bool PERM = false, AFTER_DRAIN = false;
    const float* H; float* Ho; int omask;
    __device__ __forceinline__ void operator()(const f32x4 (&acc)[2][2][4][2], const Unit& u, int wr, int wc, int fr, int fq) const {
        const int row0 = u.pm * BM + wr * 64 + fr, col0 = u.pn * BM + wc * 32 + 4 * fq;
#pragma unroll
        for (int ai = 0; ai < 2; ++ai)
#pragma unroll
            for (int m = 0; m < 4; ++m) { const int row = row0 + ai * HALF + m * 16; const float* hr = H + (size_t)row * cD + col0; float* ho = Ho + (size_t)(row & omask) * cD + col0;
#pragma unroll
                for (int bj = 0; bj < 2; ++bj)
#pragma unroll
                    for (int n = 0; n < 2; ++n) { const int off = bj * HALF + n * 16; *(f32x4*)(ho + off) = *(const f32x4*)(hr + off) + acc[ai][bj][m][n]; }
                asm volatile("" ::: "memory"); }
    }
};

template <class Epi, class Sched, bool ALIGN_EPI = false, bool SP2 = false>
__device__ __forceinline__ void gemm_phase(PG8_LAS unsigned char* lds, const Gemm g, const Sched& S, const Epi& E) {
    int tid_ = threadIdx.x; asm volatile("" : "+v"(tid_));
    const int tid = tid_, wid = __builtin_amdgcn_readfirstlane(tid >> 6), lane = tid & 63, wr = wid >> 2, wc = wid & 3, fr = lane & 15, fq = lane >> 4;
    const int K = g.K, nt = K / BK;
    unsigned voffA[2], voffB[2];
#pragma unroll
    for (int i = 0; i < 2; ++i) { int R, C; stage_rc(tid * 16 + i * 8192, R, C); const int Rb = Epi::PERM ? ((R & ~31) + perm32(R & 31)) : R;
        voffA[i] = (unsigned)(R * K + C) * 2u; voffB[i] = (unsigned)(Rb * K + C) * 2u; }
    const size_t kstep = (size_t)(BK * 2);
    const size_t hstep = (size_t)HALF * K * 2;
    const size_t tstep = 2 * hstep;
    const unsigned ldsw = (unsigned)wid * 1024u;
    const int aoff = lds_byte(wr * 64 + fr, fq * 8), boff = lds_byte(wc * 32 + fr, fq * 8);
#define PG8_SA(b, h) (((b) * 2 + (h)) * HTB)
#define PG8_SB(b, h) ((4 + (b) * 2 + (h)) * HTB)
#define PG8_STAGE(bufoff, gbase, voff) do { _Pragma("unroll") for (int _i = 0; _i < 2; ++_i) \
        __builtin_amdgcn_global_load_lds((const unsigned*)((const char*)(gbase) + (voff)[_i]), (PG8_LAS unsigned*)(lds + (bufoff) + ldsw + _i * 8192), 16, 0, 0); } while (0)
#define PG8_LDA(dst, b, h) do { _Pragma("unroll") for (int m = 0; m < 4; ++m) _Pragma("unroll") for (int k = 0; k < 2; ++k) dst[m][k] = *(const PG8_LAS bf16x8*)(lds + PG8_SA(b, h) + aoff + m * 2048 + k * 1024); } while (0)
#define PG8_LDB(dst, b, h) do { _Pragma("unroll") for (int n = 0; n < 2; ++n) _Pragma("unroll") for (int k = 0; k < 2; ++k) dst[n][k] = *(const PG8_LAS bf16x8*)(lds + PG8_SB(b, h) + boff + n * 2048 + k * 1024); } while (0)
#define PG8_MMA(ai, bj, At, Bt) do { __builtin_amdgcn_s_setprio(1); _Pragma("unroll") for (int m = 0; m < 4; ++m) _Pragma("unroll") for (int n = 0; n < 2; ++n) _Pragma("unroll") for (int k = 0; k < 2; ++k) \
        acc[ai][bj][m][n] = __builtin_amdgcn_mfma_f32_16x16x32_bf16(Bt[n][k], At[m][k], acc[ai][bj][m][n], 0, 0, 0); __builtin_amdgcn_s_setprio(0); } while (0)
#define PG8_WAIT_V(n) asm volatile("s_waitcnt vmcnt(" #n ")" ::: "memory")
#define PG8_WAIT_L(n) asm volatile("s_waitcnt lgkmcnt(" #n ")" ::: "memory")
#define PG8_BAR __builtin_amdgcn_s_barrier()
#define PG8_SCHED __builtin_amdgcn_sched_barrier(0)
    Unit cur, nxt; int ui = 0;
    if (!S.next(0, cur)) return;
    f32x4 acc[2][2][4][2];
#pragma unroll
    for (int a = 0; a < 2; ++a)
#pragma unroll
        for (int b = 0; b < 2; ++b)
#pragma unroll
            for (int m = 0; m < 4; ++m)
#pragma unroll
                for (int n = 0; n < 2; ++n) acc[a][b][m][n] = (f32x4){0.f, 0.f, 0.f, 0.f};
    bf16x8 At[4][2], B0[2][2], B1[2][2];
    const char* cA = (const char*)g.A + (size_t)cur.pm * tstep; const char* cB = (const char*)g.Bt + (size_t)cur.pn * tstep;
    S.a_ready(cur);
    if constexpr (SP2) {
        PG8_STAGE(PG8_SB(0, 0), cB, voffB); PG8_STAGE(PG8_SB(0, 1), cB + hstep, voffB); PG8_STAGE(PG8_SA(0, 0), cA, voffA); PG8_STAGE(PG8_SA(0, 1), cA + hstep, voffA);
        if (wr == 1) PG8_BAR;
        PG8_WAIT_V(2); PG8_BAR;
        PG8_STAGE(PG8_SB(1, 0), cB + kstep, voffB); PG8_STAGE(PG8_SA(1, 0), cA + kstep, voffA); PG8_STAGE(PG8_SB(1, 1), cB + hstep + kstep, voffB);
        PG8_WAIT_V(6); PG8_BAR;
    } else {
        PG8_STAGE(PG8_SB(0, 0), cB, voffB); PG8_STAGE(PG8_SA(0, 0), cA, voffA); PG8_STAGE(PG8_SB(0, 1), cB + hstep, voffB); PG8_STAGE(PG8_SA(0, 1), cA + hstep, voffA);
        if (wr == 1) PG8_BAR;
        PG8_WAIT_V(4); PG8_BAR;
        PG8_STAGE(PG8_SB(1, 0), cB + kstep, voffB); PG8_STAGE(PG8_SA(1, 0), cA + kstep, voffA); PG8_STAGE(PG8_SB(1, 1), cB + hstep + kstep, voffB);
        PG8_WAIT_V(6); PG8_BAR;
    }
    for (;;) {
        const bool has_next = S.next(ui + 1, nxt);
        const char* nA = has_next ? (const char*)g.A + (size_t)nxt.pm * tstep : cA; const char* nB = has_next ? (const char*)g.Bt + (size_t)nxt.pn * tstep : cB;
        for (int t = 0; t < nt; t += 2) {
            const bool last = (t == nt - 2);
            const char* a1 = cA + (size_t)(t + 1) * kstep;
            const char* a2 = last ? nA : cA + (size_t)(t + 2) * kstep; const char* b2 = last ? nB : cB + (size_t)(t + 2) * kstep;
            const char* a3 = a2 + kstep; const char* b3 = b2 + kstep;
            if (last && has_next) S.a_ready(nxt);
            if constexpr (SP2) {
            PG8_LDB(B0, 0, 0); PG8_LDB(B1, 0, 1); PG8_SCHED; PG8_LDA(At, 0, 0); PG8_STAGE(PG8_SA(1, 1), a1 + hstep, voffA);
            PG8_WAIT_V(8); PG8_WAIT_L(0); PG8_BAR; PG8_MMA(0, 0, At, B0); PG8_MMA(0, 1, At, B1); PG8_BAR; PG8_SCHED;
            PG8_LDA(At, 0, 1); PG8_STAGE(PG8_SB(0, 0), b2, voffB); PG8_STAGE(PG8_SB(0, 1), b2 + hstep, voffB); PG8_STAGE(PG8_SA(0, 0), a2, voffA);
            PG8_WAIT_V(8); PG8_WAIT_L(0); PG8_BAR; PG8_MMA(1, 0, At, B0); PG8_MMA(1, 1, At, B1); PG8_BAR; PG8_SCHED;
            PG8_LDB(B0, 1, 0); PG8_LDB(B1, 1, 1); PG8_SCHED; PG8_LDA(At, 1, 0); PG8_STAGE(PG8_SA(0, 1), a2 + hstep, voffA);
            PG8_WAIT_V(8); PG8_WAIT_L(0); PG8_BAR; PG8_MMA(0, 0, At, B0); PG8_MMA(0, 1, At, B1); PG8_BAR; PG8_SCHED;
            PG8_LDA(At, 1, 1); PG8_STAGE(PG8_SB(1, 0), b3, voffB); PG8_STAGE(PG8_SB(1, 1), b3 + hstep, voffB); PG8_STAGE(PG8_SA(1, 0), a3, voffA);
            PG8_WAIT_V(8); PG8_WAIT_L(0); PG8_BAR; PG8_MMA(1, 0, At, B0); PG8_MMA(1, 1, At, B1); PG8_BAR; PG8_SCHED;
            } else {
            PG8_LDB(B0, 0, 0); PG8_SCHED; PG8_LDA(At, 0, 0); PG8_STAGE(PG8_SA(1, 1), a1 + hstep, voffA);
            PG8_WAIT_L(8); PG8_BAR; PG8_WAIT_L(0); PG8_MMA(0, 0, At, B0); PG8_BAR; PG8_SCHED;
            PG8_LDB(B1, 0, 1); PG8_STAGE(PG8_SB(0, 0), b2, voffB);
            PG8_BAR; PG8_WAIT_L(0); PG8_MMA(0, 1, At, B1); PG8_BAR;
            PG8_LDA(At, 0, 1); PG8_STAGE(PG8_SA(0, 0), a2, voffA);
            PG8_BAR; PG8_WAIT_L(0); PG8_MMA(1, 0, At, B0); PG8_BAR; PG8_SCHED;
            PG8_STAGE(PG8_SB(0, 1), b2 + hstep, voffB);
            PG8_WAIT_V(6); PG8_BAR; PG8_MMA(1, 1, At, B1); PG8_BAR;
            PG8_LDB(B0, 1, 0); PG8_SCHED; PG8_LDA(At, 1, 0); PG8_STAGE(PG8_SA(0, 1), a2 + hstep, voffA);
            PG8_WAIT_L(8); PG8_BAR; PG8_WAIT_L(0); PG8_MMA(0, 0, At, B0); PG8_BAR; PG8_SCHED;
            PG8_LDB(B1, 1, 1); PG8_STAGE(PG8_SB(1, 0), b3, voffB);
            PG8_BAR; PG8_WAIT_L(0); PG8_MMA(0, 1, At, B1); PG8_BAR;
            PG8_LDA(At, 1, 1); PG8_STAGE(PG8_SA(1, 0), a3, voffA);
            PG8_BAR; PG8_WAIT_L(0); PG8_MMA(1, 0, At, B0); PG8_BAR; PG8_SCHED;
            PG8_STAGE(PG8_SB(1, 1), b3 + hstep, voffB);
            PG8_WAIT_V(6); PG8_BAR; PG8_MMA(1, 1, At, B1); PG8_BAR;
            }
        }
        if constexpr (ALIGN_EPI) { if (wr == 0) PG8_BAR; }
        if constexpr (!Epi::AFTER_DRAIN) { E(acc, cur, wr, wc, fr, fq); S.done(cur); }
        if (!has_next) break;
#pragma unroll
        for (int a = 0; a < 2; ++a)
#pragma unroll
            for (int b = 0; b < 2; ++b)
#pragma unroll
                for (int m = 0; m < 4; ++m)
#pragma unroll
                    for (int n = 0; n < 2; ++n) acc[a][b][m][n] = (f32x4){0.f, 0.f, 0.f, 0.f};
        cur = nxt; cA = nA; cB = nB; ++ui;
        if constexpr (ALIGN_EPI) { if (wr == 1) PG8_BAR; }
    }
    PG8_WAIT_V(0);
    if constexpr (!ALIGN_EPI) { if (wr == 0) PG8_BAR; }
    PG8_BAR;
    if constexpr (Epi::AFTER_DRAIN) { E.fused(acc, cur, wr, wc, fr, fq, lds, wid, lane); S.done(cur); }
#undef PG8_SA
#undef PG8_SB
#undef PG8_STAGE
#undef PG8_LDA
#undef PG8_LDB
#undef PG8_MMA
#undef PG8_WAIT_V
#undef PG8_WAIT_L
#undef PG8_BAR
#undef PG8_SCHED
}
}
#ifndef PG8_SP2
#define PG8_SP2 true
#endif
#ifndef PG8_ALIGN
#define PG8_ALIGN true
#endif
constexpr int NWAVES = 8;
#ifndef PROBE_REP
#define PROBE_REP -1
#endif
#ifndef MK_N_LAUNCHES
#define MK_N_LAUNCHES 1
#endif
constexpr int PER_PHASE = 9;
constexpr int N_LAUNCHES = MK_N_LAUNCHES;

constexpr int D = 1024, NP = 16384, NS = 1024, M = NP + NS, FF = 4096, NPROJ = 2816, LDP = 2560;
constexpr int SEQ = 2048, NB = 8, NH = 4, DK = 64, DV = 128, NCH = SEQ / 64, DECB = 128, DECS = 8;
constexpr int PQ = 0, PK = 256, PV = 512, POG = 1024, PU = 1536, PVC = 2048;
constexpr float EPS = 1e-6f;
constexpr int NITEM_GLA = NB * NH * NCH;
constexpr size_t OUT_Y = 0, OUT_SP = (size_t)M * D, OUT_SS = OUT_SP + (size_t)NB * NH * DK * DV, OUT_VS = OUT_SS + (size_t)DECB * NH * DK * DV;

constexpr size_t MiB = 1u << 20;
constexpr size_t WS_CTL = 0, CTL_ZERO_BYTES = 256 * 1024;
constexpr size_t WS_RSS = 128 * 1024;
constexpr size_t WS_WIN = 2 * MiB, WS_WO = 8 * MiB, WS_WUP = 10 * MiB, WS_WDN = 18 * MiB;
constexpr size_t WS_GLR = 26 * MiB;
constexpr size_t WS_DEC = 28 * MiB;
constexpr size_t WS_XN = 30 * MiB;
constexpr size_t WS_PROJ = 64 * MiB;
constexpr size_t WS_U = 149 * MiB;
constexpr size_t WS_MIX = 181 * MiB;
constexpr size_t WS_ACT = 64 * MiB;
constexpr size_t WS_US = 215 * MiB;
constexpr size_t WS_DUMMY = 29 * MiB;
constexpr size_t WS_END = 247 * MiB;
static_assert(WS_PROJ + (size_t)M * LDP * 2 <= WS_U && WS_U + (size_t)NITEM_GLA * DK * DV * 4 <= WS_MIX && WS_MIX + (size_t)M * D * 2 <= WS_US && WS_US + (size_t)NITEM_GLA * DK * DV * 4 <= WS_END && WS_ACT + (size_t)M * FF * 2 <= WS_END && WS_XN + (size_t)M * D * 2 <= WS_PROJ, "d_ws map");
static_assert(WS_GLR + (size_t)M * 16 * 4 <= WS_DEC && WS_DEC + (size_t)NITEM_GLA * 64 * 4 <= WS_XN && WS_WIN + (size_t)NPROJ * D * 2 <= WS_WO && WS_RSS + (size_t)M * 4 <= CTL_ZERO_BYTES, "d_ws map 2");
constexpr int CW_TMO = 0, CW_CODE = 1;
constexpr int CW_BAR = 4096;

constexpr int RING_OFF = 0, RING_BYTES = 131072;
constexpr int LDSCTL_OFF = RING_BYTES, MISC_OFF = LDSCTL_OFF + 320;
constexpr int LDS_BYTES = 147456;
static_assert(MISC_OFF + 128 <= LDS_BYTES, "LDS map");

#define GAS __attribute__((address_space(1)))
#define LAS __attribute__((address_space(3)))
typedef unsigned short bf16;
typedef unsigned v4u __attribute__((ext_vector_type(4)));
typedef unsigned v2u __attribute__((ext_vector_type(2)));
typedef float f32x4 __attribute__((ext_vector_type(4)));
typedef float f32x2 __attribute__((ext_vector_type(2)));
typedef short bf16x8 __attribute__((ext_vector_type(8)));
typedef GAS unsigned gu32;
typedef GAS unsigned long long gu64;
#define RLX_AGENT __ATOMIC_RELAXED, __HIP_MEMORY_SCOPE_AGENT
#define LDS_WAIT() asm volatile("s_waitcnt lgkmcnt(0)" ::: "memory")
#define VM_WAIT() asm volatile("s_waitcnt vmcnt(0)" ::: "memory")
__device__ __forceinline__ unsigned f2bf(float f) { unsigned u = __builtin_bit_cast(unsigned, f); return (u + 0x7fffu + ((u >> 16) & 1u)) >> 16; }
__device__ __forceinline__ unsigned pk2(float lo, float hi) { return f2bf(lo) | (f2bf(hi) << 16); }
__device__ __forceinline__ float bf2f(unsigned b) { return __builtin_bit_cast(float, b << 16); }
__device__ __forceinline__ float bflo(unsigned w) { return __builtin_bit_cast(float, w << 16); }
__device__ __forceinline__ float bfhi(unsigned w) { return __builtin_bit_cast(float, w & 0xffff0000u); }

#define XB_TMO      128
#define XB_XCNT(j)  (256  + 64 * (j))
#define XB_XSUB(j)  (1280 + 64 * (j))
#define XB_XGEN(j)  (2304 + 64 * (j))
#define XB_TOP      3328
#define XB_TOPGEN   3392
#define XCD_BAR_WORDS 3456
#define XB_SPIN_CAP (1u << 18)

__device__ __forceinline__ unsigned xb_ld(unsigned* p)              { return __hip_atomic_load(p, __ATOMIC_RELAXED, __HIP_MEMORY_SCOPE_AGENT); }
__device__ __forceinline__ unsigned xb_add(unsigned* p, unsigned v) { return __hip_atomic_fetch_add(p, v, __ATOMIC_RELAXED, __HIP_MEMORY_SCOPE_AGENT); }
__device__ __forceinline__ unsigned xb_xcc_id() { return (unsigned)__builtin_amdgcn_s_getreg((3 << 11) | 20) & 0xFu; }
#define XB_SPIN(cond, bar) do { unsigned _sp = 0; while (cond) { __builtin_amdgcn_s_sleep(1); \
    if ((++_sp & 255u) == 0u) { if (xb_ld(&(bar)[XB_TMO])) break; if (_sp > XB_SPIN_CAP) { atomicAdd(&(bar)[XB_TMO], 1u); break; } } } } while (0)

struct XcdBarrier {
    unsigned* bar; unsigned x;
    volatile LAS unsigned* st;
};

__device__ __forceinline__ XcdBarrier xcd_barrier_post(unsigned* bar, volatile LAS unsigned* st) {
    XcdBarrier b; b.bar = bar; b.x = xb_xcc_id(); b.st = st;
    if (threadIdx.x == 0) (void)xb_add(&bar[XB_XCNT(b.x)], 1u);
    return b;
}
__device__ __forceinline__ void xcd_barrier_complete(unsigned* bar, unsigned x, unsigned& nloc, unsigned& nx) {
    const unsigned G = gridDim.x * gridDim.y * gridDim.z;
    unsigned sum, cnt, mine, sp = 0u;
    for (;;) {
        sum = 0u; cnt = 0u; mine = 0u;
#pragma unroll
        for (unsigned j = 0; j < 16; ++j) { const unsigned c = xb_ld(&bar[XB_XCNT(j)]); sum += c; cnt += (c > 0u) ? 1u : 0u; mine = (j == x) ? c : mine; }
        if (sum == G) break;
        __builtin_amdgcn_s_sleep(1);
        if ((++sp & 255u) == 0u) { if (xb_ld(&bar[XB_TMO])) break; if (sp > XB_SPIN_CAP) { atomicAdd(&bar[XB_TMO], 1u); break; } }
    }
    nloc = mine > 0u ? mine : 1u; nx = cnt > 0u ? cnt : 1u;
}

__device__ __forceinline__ void xcd_barrier(const XcdBarrier& b) {
    asm volatile("s_waitcnt vmcnt(0)" ::: "memory");
    __syncthreads();
    if (threadIdx.x == 0) {
        unsigned* bar = b.bar;
        __builtin_amdgcn_s_waitcnt(0);
        unsigned nloc = b.st[0], nx = b.st[1];
        if (nloc == 0u) { xcd_barrier_complete(bar, b.x, nloc, nx); b.st[0] = nloc; b.st[1] = nx; }
        const unsigned old = xb_add(&bar[XB_XSUB(b.x)], 1u);
        const unsigned gen = old / nloc;
        if (old + 1u == (gen + 1u) * nloc) {
            __builtin_amdgcn_fence(__ATOMIC_RELEASE, "agent");
            asm volatile("s_waitcnt vmcnt(0)" ::: "memory");
            const unsigned og = xb_add(&bar[XB_TOP], 1u);
            const unsigned tg = og / nx;
            if (og + 1u == (tg + 1u) * nx) xb_add(&bar[XB_TOPGEN], 1u);
            else XB_SPIN(xb_ld(&bar[XB_TOPGEN]) == tg, bar);
            __builtin_amdgcn_fence(__ATOMIC_ACQUIRE, "agent");
            xb_add(&bar[XB_XGEN(b.x)], 1u);
            asm volatile("s_waitcnt vmcnt(0)" ::: "memory");
        } else {
            XB_SPIN(xb_ld(&bar[XB_XGEN(b.x)]) == gen, bar);
            __builtin_amdgcn_fence(__ATOMIC_ACQUIRE, "agent");
            asm volatile("s_waitcnt vmcnt(0)" ::: "memory");
        }
    }
    __syncthreads();
}

struct Frame {
    LAS unsigned char* lds;
    volatile LAS unsigned* MISC;
    gu32* ctl;
    int tid, lane, wave;
    int vcu, G;
    const float *xp, *xs, *state, *g_mix, *w_in, *w_gu, *b_gate, *g_on, *ln_g, *ln_b, *w_s, *b_s, *w_o, *g_ffn, *w_up, *w_dn, *g_fin;
    float* out;
    bf16 *WinT, *WoT, *WupT, *WdnT, *XN, *PROJ, *MIX, *ACT;
    float *GLR, *DEC, *U, *US, *RSS;
};

__device__ __forceinline__ float wave_sum(float v) {
#pragma unroll
    for (int o = 1; o < 64; o <<= 1) v += __shfl_xor(v, o);
    return v;
}
__device__ __forceinline__ float logsig(float z) { return fminf(z, 0.f) - __logf(1.f + __expf(-fabsf(z))); }
__device__ __forceinline__ float silu(float x) { return x * __builtin_amdgcn_rcpf(1.f + __expf(-x)); }
__device__ __forceinline__ bf16x8 ldfrag(const LAS bf16* X, int LD, int r0, int k0, int lane) { return *(const LAS bf16x8*)(X + (r0 + (lane & 15)) * LD + k0 + 8 * (lane >> 4)); }
__device__ __forceinline__ bf16x8 frag_gather(const LAS bf16* X, int LD, int k0, int c0, int lane) {
    const LAS bf16* p = X + (k0 + 8 * (lane >> 4)) * LD + c0 + (lane & 15);
    bf16x8 r;
#pragma unroll
    for (int j = 0; j < 8; ++j) r[j] = (short)p[j * LD];
    return r;
}
#define MFMA16(a, b, c) __builtin_amdgcn_mfma_f32_16x16x32_bf16((a), (b), (c), 0, 0, 0)

__device__ __forceinline__ void p0_transpose_item(const float* W, int K, int Nsrc, bf16* WT, const float* gk, int mode, LAS float* scr, int kb, int nb, int lane) {
    const int k0 = 64 * kb, n0 = 32 * nb, n = n0 + (lane & 31);
    int src = n;
    if (mode == 1) src = n < 1024 ? n : (n < 2560 ? n + 16 : (n < 2576 ? n - 1536 : -1));
#pragma unroll 8
    for (int i = 0; i < 32; ++i) { const int kk = 2 * i + (lane >> 5); float v = 0.f;
        if (src >= 0) { v = W[(size_t)(k0 + kk) * Nsrc + src]; if (gk) v *= gk[k0 + kk]; }
        scr[kk * 33 + (lane & 31)] = v; }
    LDS_WAIT(); asm volatile("" ::: "memory");
    const int c = lane & 7;
#pragma unroll
    for (int j = 0; j < 4; ++j) { const int nn = (lane >> 3) + 8 * j; const LAS float* s = scr + (8 * c) * 33 + nn;
        v4u o; o.x = pk2(s[0 * 33], s[1 * 33]); o.y = pk2(s[2 * 33], s[3 * 33]); o.z = pk2(s[4 * 33], s[5 * 33]); o.w = pk2(s[6 * 33], s[7 * 33]);
        *(GAS v4u*)(WT + (size_t)(n0 + nn) * K + k0 + 8 * c) = o; }
    LDS_WAIT(); asm volatile("" ::: "memory");
}
__device__ __forceinline__ void rms_row_to_bf16(const float* xrow, bf16* orow, int lane) {
    const GAS f32x4* xr = (const GAS f32x4*)xrow + lane;
    f32x4 v[4]; float s = 0.f;
#pragma unroll
    for (int j = 0; j < 4; ++j) { v[j] = xr[64 * j]; s += (v[j].x * v[j].x + v[j].y * v[j].y) + (v[j].z * v[j].z + v[j].w * v[j].w); }
    const float rstd = 1.f / sqrtf(wave_sum(s) * (1.f / D) + EPS);
    GAS unsigned long long* o8 = (GAS unsigned long long*)orow + lane;
#pragma unroll
    for (int j = 0; j < 4; ++j) o8[64 * j] = (unsigned long long)pk2(v[j].x * rstd, v[j].y * rstd) | ((unsigned long long)pk2(v[j].z * rstd, v[j].w * rstd) << 32);
}
__device__ __forceinline__ void p0_prologue(Frame& F) {
    LAS float* scr = (LAS float*)(F.lds + RING_OFF + F.wave * 16384);
    const int gw = F.vcu * NWAVES + F.wave, NGW = F.G * NWAVES;
    constexpr int I_IN = (D / 64) * (NPROJ / 32), I_O = (D / 64) * (D / 32), I_UP = (D / 64) * (FF / 32), I_DN = (FF / 64) * (D / 32);
    constexpr int NITEMS = I_IN + I_O + I_UP + I_DN;
    for (int it = gw; it < NITEMS; it += NGW) {
        int r = it;
        if (r < I_IN) { p0_transpose_item(F.w_in, D, 2576, F.WinT, F.g_mix, 1, scr, r / (NPROJ / 32), r % (NPROJ / 32), F.lane); continue; } r -= I_IN;
        if (r < I_O) { p0_transpose_item(F.w_o, D, D, F.WoT, nullptr, 0, scr, r / (D / 32), r % (D / 32), F.lane); continue; } r -= I_O;
        if (r < I_UP) { p0_transpose_item(F.w_up, D, FF, F.WupT, F.g_ffn, 0, scr, r / (FF / 32), r % (FF / 32), F.lane); continue; } r -= I_UP;
        p0_transpose_item(F.w_dn, FF, D, F.WdnT, nullptr, 0, scr, r / (D / 32), r % (D / 32), F.lane);
    }
    for (int m = gw; m < M; m += NGW) rms_row_to_bf16(m < NP ? F.xp + (size_t)m * D : F.xs + (size_t)(m - NP) * D, F.XN + (size_t)m * D, F.lane);
}

#define GLA_LOAD_GATEW() float wg[16]; _Pragma("unroll") for (int r = 0; r < 16; ++r) wg[r] = F.w_gu[r * 256 + h * 64 + d]; const float bg = F.b_gate[h * 64 + d]

__device__ __forceinline__ void gla_local_item(Frame& F, int id) {
    const int bh = id >> 5, c = id & 31, b = bh >> 2, h = bh & 3, r0 = b * SEQ + c * 64;
    LAS unsigned char* L = F.lds;
    LAS float* glr_s = (LAS float*)L;
    LAS float* wtot = (LAS float*)(L + 4096);
    LAS bf16* kdT = (LAS bf16*)(L + 6144);
    LAS bf16* Vs = (LAS bf16*)(L + 15360);
    const int tid = F.tid, lane = F.lane, w = F.wave, d = lane, fr = lane & 15, fq = lane >> 4;
    if (tid < 256) ((LAS f32x4*)glr_s)[tid] = ((const GAS f32x4*)(F.GLR + (size_t)r0 * 16))[tid];
    { const int t = tid >> 3, sg = (tid & 7) * 16; const GAS v4u* src = (const GAS v4u*)(F.PROJ + (size_t)(r0 + t) * LDP + PV + h * DV + sg);
      const v4u a = src[0], bq = src[1]; LAS v4u* dst = (LAS v4u*)(Vs + t * 136 + sg); dst[0] = a; dst[1] = bq; }
    float kv[8];
#pragma unroll
    for (int tt = 0; tt < 8; ++tt) kv[tt] = bf2f(((const GAS bf16*)F.PROJ)[(size_t)(r0 + 8 * w + tt) * LDP + PK + h * DK + d]);
    GLA_LOAD_GATEW();
    __syncthreads();
    float cs[8], run = 0.f;
#pragma unroll
    for (int tt = 0; tt < 8; ++tt) { const LAS float* gl = glr_s + (8 * w + tt) * 16; float z = bg;
#pragma unroll
        for (int r = 0; r < 16; ++r) z += gl[r] * wg[r];
        run += logsig(z) * (1.f / 16.f); cs[tt] = run; }
    wtot[w * 64 + d] = run;
    __syncthreads();
    float off = 0.f, tot = 0.f;
#pragma unroll
    for (int w2 = 0; w2 < 8; ++w2) { const float x = wtot[w2 * 64 + d]; tot += x; if (w2 < w) off += x; }
    { v4u pk;
      pk.x = pk2(kv[0] * __expf(tot - off - cs[0]), kv[1] * __expf(tot - off - cs[1])); pk.y = pk2(kv[2] * __expf(tot - off - cs[2]), kv[3] * __expf(tot - off - cs[3]));
      pk.z = pk2(kv[4] * __expf(tot - off - cs[4]), kv[5] * __expf(tot - off - cs[5])); pk.w = pk2(kv[6] * __expf(tot - off - cs[6]), kv[7] * __expf(tot - off - cs[7]));
      *(LAS v4u*)(kdT + d * 72 + 8 * w) = pk; }
    if (w == 0) ((GAS float*)F.DEC)[(size_t)id * 64 + d] = __expf(tot);
    __syncthreads();
    f32x4 acc[4];
#pragma unroll
    for (int q = 0; q < 4; ++q) acc[q] = (f32x4){0.f, 0.f, 0.f, 0.f};
#pragma unroll
    for (int ks = 0; ks < 2; ++ks) { const bf16x8 xa = frag_gather(Vs, 136, 32 * ks, 16 * w, lane);
#pragma unroll
        for (int db = 0; db < 4; ++db) { const bf16x8 xb = ldfrag(kdT, 72, 16 * db, 32 * ks, lane); acc[db] = MFMA16(xa, xb, acc[db]); } }
    GAS float* Uo = (GAS float*)F.U + (size_t)id * 8192;
#pragma unroll
    for (int db = 0; db < 4; ++db) *(GAS f32x4*)(Uo + (16 * db + fr) * 128 + 16 * w + 4 * fq) = acc[db];
    __syncthreads();
}

__device__ __forceinline__ void gla_sample_item(Frame& F, int it) {
    const int b = it >> 2, h = it & 3, r0 = NP + b * DECS;
    LAS unsigned char* L = F.lds;
    LAS float* S0s = (LAS float*)L;
    LAS float* glr_s = (LAS float*)(L + 32768);
    LAS float* gs = (LAS float*)(L + 33280);
    LAS float* qs = (LAS float*)(L + 35328);
    LAS float* ks = (LAS float*)(L + 37376);
    LAS float* kds = (LAS float*)(L + 39424);
    LAS float* dec_s = (LAS float*)(L + 41472);
    LAS float* vs_ = (LAS float*)(L + 41728);
    LAS float* Ps = (LAS float*)(L + 45824);
    LAS float* os = (LAS float*)(L + 46080);
    const int tid = F.tid, lane = F.lane, w = F.wave, d = lane, t = w;
    { const GAS f32x4* s0 = (const GAS f32x4*)(F.state + (size_t)it * 8192);
#pragma unroll
      for (int k = 0; k < 4; ++k) ((LAS f32x4*)S0s)[tid + 512 * k] = s0[tid + 512 * k]; }
    if (tid < 32) ((LAS f32x4*)glr_s)[tid] = ((const GAS f32x4*)(F.GLR + (size_t)r0 * 16))[tid];
    { const int tv = tid >> 6, dv2 = (tid & 63) * 2; const unsigned wv = *(const GAS unsigned*)(F.PROJ + (size_t)(r0 + tv) * LDP + PV + h * DV + dv2); vs_[tv * 128 + dv2] = bflo(wv); vs_[tv * 128 + dv2 + 1] = bfhi(wv); }
    const float qv = bf2f(((const GAS bf16*)F.PROJ)[(size_t)(r0 + t) * LDP + PQ + h * DK + d]), kv = bf2f(((const GAS bf16*)F.PROJ)[(size_t)(r0 + t) * LDP + PK + h * DK + d]);
    GLA_LOAD_GATEW();
    __syncthreads();
    { float z = bg;
#pragma unroll
      for (int r = 0; r < 16; ++r) z += glr_s[t * 16 + r] * wg[r];
      gs[t * 64 + d] = logsig(z) * (1.f / 16.f); }
    __syncthreads();
    { float bt = 0.f, tot = 0.f;
#pragma unroll
      for (int t2 = 0; t2 < 8; ++t2) { const float x = gs[t2 * 64 + d]; tot += x; if (t2 <= t) bt += x; }
      qs[t * 64 + d] = qv * __expf(bt); ks[t * 64 + d] = kv * __expf(-bt); kds[t * 64 + d] = kv * __expf(tot - bt); if (t == 0) dec_s[d] = __expf(tot); }
    __syncthreads();
    { const int pair = tid >> 3, part = tid & 7, i = pair >> 3, j = pair & 7; float s = 0.f;
#pragma unroll
      for (int dd = 0; dd < 8; ++dd) s += qs[i * 64 + part * 8 + dd] * ks[j * 64 + part * 8 + dd];
      s += __shfl_xor(s, 1); s += __shfl_xor(s, 2); s += __shfl_xor(s, 4);
      if (part == 0) Ps[i * 8 + j] = (j <= i) ? s : 0.f; }
    __syncthreads();
    { const int dv = tid & 127, i0 = 2 * (tid >> 7), i1 = i0 + 1; float o0 = 0.f, o1 = 0.f;
#pragma unroll 8
      for (int dd = 0; dd < 64; ++dd) { const float s = S0s[dd * 128 + dv]; o0 += qs[i0 * 64 + dd] * s; o1 += qs[i1 * 64 + dd] * s; }
#pragma unroll
      for (int j = 0; j < 8; ++j) { const float v = vs_[j * 128 + dv]; o0 += Ps[i0 * 8 + j] * v; o1 += Ps[i1 * 8 + j] * v; }
      os[i0 * 128 + dv] = o0; os[i1 * 128 + dv] = o1; }
    { const int dv4 = tid & 31, dg = tid >> 5; GAS float* So = (GAS float*)F.out + OUT_SS + (size_t)it * 8192;
#pragma unroll
      for (int q = 0; q < 4; ++q) { const int dd = dg * 4 + q; f32x4 s = ((LAS f32x4*)S0s)[dd * 32 + dv4] * dec_s[dd];
#pragma unroll
          for (int j = 0; j < 8; ++j) s += ((LAS f32x4*)vs_)[j * 32 + dv4] * kds[j * 64 + dd];
          *(GAS f32x4*)(So + dd * 128 + 4 * dv4) = s; } }
    __syncthreads();
    { const int i = w; const float o0 = os[i * 128 + 2 * lane], o1 = os[i * 128 + 2 * lane + 1];
      const float rstd = 1.f / sqrtf(wave_sum(o0 * o0 + o1 * o1) * (1.f / DV) + EPS);
      const unsigned ogw = *(const GAS unsigned*)(F.PROJ + (size_t)(r0 + i) * LDP + POG + h * DV + 2 * lane);
      const float y0 = o0 * rstd * F.g_on[2 * lane] * silu(bflo(ogw)), y1 = o1 * rstd * F.g_on[2 * lane + 1] * silu(bfhi(ogw));
      *(GAS unsigned*)(F.MIX + (size_t)(r0 + i) * D + h * DV + 2 * lane) = pk2(y0, y1); }
    __syncthreads();
}

__device__ __forceinline__ void cmlp_sample_item(Frame& F, int b) {
    const int r0 = NP + b * DECS;
    LAS float* vn_s = (LAS float*)F.lds;
    const int tid = F.tid, lane = F.lane, w = F.wave;
    { const int i = w; const v4u raw = *(const GAS v4u*)(F.PROJ + (size_t)(r0 + i) * LDP + PVC + 8 * lane);
      float x[8] = {bflo(raw.x), bfhi(raw.x), bflo(raw.y), bfhi(raw.y), bflo(raw.z), bfhi(raw.z), bflo(raw.w), bfhi(raw.w)};
      float s = 0.f;
#pragma unroll
      for (int e = 0; e < 8; ++e) s += x[e];
      const float mean = wave_sum(s) * (1.f / 512.f); float q = 0.f;
#pragma unroll
      for (int e = 0; e < 8; ++e) { x[e] -= mean; q += x[e] * x[e]; }
      const float rstd = 1.f / sqrtf(wave_sum(q) * (1.f / 512.f) + EPS);
      f32x4 o0, o1;
#pragma unroll
      for (int e = 0; e < 8; ++e) { const float y = x[e] * rstd * F.ln_g[8 * lane + e] + F.ln_b[8 * lane + e]; vn_s[i * 512 + 8 * lane + e] = y; if (e < 4) o0[e] = y; else o1[e - 4] = y; }
      GAS f32x4* vo = (GAS f32x4*)((GAS float*)F.out + OUT_VS + (size_t)(b * DECS + i) * 512 + 8 * lane); vo[0] = o0; vo[1] = o1; }
    __syncthreads();
    { const int ch = tid, h = ch >> 7;
#pragma unroll
      for (int i = 0; i < 8; ++i) { float s = F.b_s[h * 128 + i];
#pragma unroll
          for (int j = 0; j <= i; ++j) s += F.w_s[h * 16384 + i * 128 + j] * vn_s[j * 512 + ch];
          const float ug = bf2f(((const GAS bf16*)F.PROJ)[(size_t)(r0 + i) * LDP + PU + ch]);
          ((GAS bf16*)F.MIX)[(size_t)(r0 + i) * D + 512 + ch] = (bf16)f2bf(ug * s); } }
    __syncthreads();
}

__device__ __forceinline__ void gla_scan(Frame& F) {
    for (int gid = F.vcu * 512 + F.tid; gid < 32 * 4096; gid += F.G * 512) {
        const int bh = gid >> 12, e2 = gid & 4095, dk = e2 >> 6;
        const GAS f32x2* Up = (const GAS f32x2*)((GAS float*)F.U + (size_t)bh * 32 * 8192) + e2; GAS f32x2* Sp = (GAS f32x2*)((GAS float*)F.US + (size_t)bh * 32 * 8192) + e2; const GAS float* Dp = (const GAS float*)F.DEC + (size_t)bh * 32 * 64 + dk;
        f32x2 S = (f32x2){0.f, 0.f};
        for (int c0 = 0; c0 < 32; c0 += 8) { f32x2 u[8]; float dc[8];
#pragma unroll
            for (int k = 0; k < 8; ++k) { u[k] = Up[(size_t)(c0 + k) * 4096]; dc[k] = Dp[(c0 + k) * 64]; }
#pragma unroll
            for (int k = 0; k < 8; ++k) { Sp[(size_t)(c0 + k) * 4096] = S; S = S * dc[k] + u[k]; } }
        *(GAS f32x2*)((GAS float*)F.out + OUT_SP + (size_t)bh * 8192 + 2 * e2) = S;
    }
}

__device__ __forceinline__ void cmlp_prompt_item(Frame& F, int it) {
    const int b = it >> 5, chk = (it >> 1) & 15, gp = it & 1, r0 = b * SEQ + chk * 128;
    LAS unsigned char* L = F.lds;
    LAS float* stats = (LAS float*)L;
    LAS bf16* Wm = (LAS bf16*)(L + 1024);
    LAS bf16* vns = (LAS bf16*)(L + 1024 + 34816);
    const int tid = F.tid, lane = F.lane, w = F.wave, fr = lane & 15, fq = lane >> 4;
    for (int q = 0; q < 16; ++q) { const int t = 16 * w + q; const v4u raw = *(const GAS v4u*)(F.PROJ + (size_t)(r0 + t) * LDP + PVC + 8 * lane);
        float x[8] = {bflo(raw.x), bfhi(raw.x), bflo(raw.y), bfhi(raw.y), bflo(raw.z), bfhi(raw.z), bflo(raw.w), bfhi(raw.w)};
        float s = 0.f;
#pragma unroll
        for (int e = 0; e < 8; ++e) s += x[e];
        const float mean = wave_sum(s) * (1.f / 512.f); float qq = 0.f;
#pragma unroll
        for (int e = 0; e < 8; ++e) { x[e] -= mean; qq += x[e] * x[e]; }
        const float rstd = 1.f / sqrtf(wave_sum(qq) * (1.f / 512.f) + EPS);
        if (lane == 0) { stats[2 * t] = mean; stats[2 * t + 1] = rstd; } }
    __syncthreads();
    for (int g2 = 0; g2 < 2; ++g2) { const int h = 2 * gp + g2;
        { const int i = tid >> 2, js = (tid & 3) * 32; const GAS f32x4* wp = (const GAS f32x4*)(F.w_s + (size_t)h * 16384 + i * 128 + js);
#pragma unroll
          for (int q = 0; q < 4; ++q) { f32x4 a = wp[2 * q], cc = wp[2 * q + 1]; const int j0 = js + 8 * q;
#pragma unroll
              for (int e = 0; e < 4; ++e) { if (j0 + e > i) a[e] = 0.f; if (j0 + 4 + e > i) cc[e] = 0.f; }
              v4u o; o.x = pk2(a[0], a[1]); o.y = pk2(a[2], a[3]); o.z = pk2(cc[0], cc[1]); o.w = pk2(cc[2], cc[3]); *(LAS v4u*)(Wm + i * 136 + j0) = o; } }
        { const int t = tid >> 2, cs = (tid & 3) * 32; const float mean = stats[2 * t], rstd = stats[2 * t + 1]; const GAS v4u* vp = (const GAS v4u*)(F.PROJ + (size_t)(r0 + t) * LDP + PVC + h * 128 + cs);
#pragma unroll
          for (int q = 0; q < 4; ++q) { const v4u raw = vp[q]; const int c0 = h * 128 + cs + 8 * q;
              float x[8] = {bflo(raw.x), bfhi(raw.x), bflo(raw.y), bfhi(raw.y), bflo(raw.z), bfhi(raw.z), bflo(raw.w), bfhi(raw.w)};
#pragma unroll
              for (int e = 0; e < 8; ++e) x[e] = (x[e] - mean) * rstd * F.ln_g[c0 + e] + F.ln_b[c0 + e];
              v4u o; o.x = pk2(x[0], x[1]); o.y = pk2(x[2], x[3]); o.z = pk2(x[4], x[5]); o.w = pk2(x[6], x[7]); *(LAS v4u*)(vns + t * 136 + cs + 8 * q) = o; } }
        __syncthreads();
        f32x4 acc[8];
#pragma unroll
        for (int q = 0; q < 8; ++q) acc[q] = (f32x4){0.f, 0.f, 0.f, 0.f};
#pragma unroll
        for (int ks = 0; ks < 4; ++ks) { const bf16x8 xa = frag_gather(vns, 136, 32 * ks, 16 * w, lane);
#pragma unroll
            for (int ib = 0; ib < 8; ++ib) if (ib >= 2 * ks) { const bf16x8 xb = ldfrag(Wm, 136, 16 * ib, 32 * ks, lane); acc[ib] = MFMA16(xa, xb, acc[ib]); } }
#pragma unroll
        for (int ib = 0; ib < 8; ++ib) { const int i = 16 * ib + fr, chn = h * 128 + 16 * w + 4 * fq; const float bs = F.b_s[h * 128 + i];
            const v2u uw = *(const GAS v2u*)(F.PROJ + (size_t)(r0 + i) * LDP + PU + chn);
            v2u o; o.x = pk2(bflo(uw.x) * (acc[ib][0] + bs), bfhi(uw.x) * (acc[ib][1] + bs)); o.y = pk2(bflo(uw.y) * (acc[ib][2] + bs), bfhi(uw.y) * (acc[ib][3] + bs));
            *(GAS v2u*)(F.MIX + (size_t)(r0 + i) * D + 512 + chn) = o; }
        __syncthreads();
    }
}

__device__ __forceinline__ void gla_out_item(Frame& F, int id) {
    const int bh = id >> 5, c = id & 31, b = bh >> 2, h = bh & 3, r0 = b * SEQ + c * 64;
    LAS unsigned char* L = F.lds;
    LAS float* glr_s = (LAS float*)L;
    LAS float* wtot = (LAS float*)(L + 4096);
    LAS bf16* qt = (LAS bf16*)(L + 6144);
    LAS bf16* kt = (LAS bf16*)(L + 15360);
    LAS bf16* Pm = (LAS bf16*)(L + 24576);
    LAS bf16* Vs = (LAS bf16*)(L + 33792);
    LAS bf16* SB = (LAS bf16*)(L + 51200);
    LAS float* os = (LAS float*)(L + 68608);
    const int tid = F.tid, lane = F.lane, w = F.wave, d = lane, fr = lane & 15, fq = lane >> 4;
    if (tid < 256) ((LAS f32x4*)glr_s)[tid] = ((const GAS f32x4*)(F.GLR + (size_t)r0 * 16))[tid];
    { const int t = tid >> 3, sg = (tid & 7) * 16; const GAS v4u* src = (const GAS v4u*)(F.PROJ + (size_t)(r0 + t) * LDP + PV + h * DV + sg);
      const v4u a = src[0], bq = src[1]; LAS v4u* dst = (LAS v4u*)(Vs + t * 136 + sg); dst[0] = a; dst[1] = bq; }
    { const int dkk = tid >> 3, sg = (tid & 7) * 16; const GAS f32x4* sp = (const GAS f32x4*)((GAS float*)F.US + (size_t)id * 8192 + dkk * 128 + sg);
      const f32x4 a0 = sp[0], a1 = sp[1], a2 = sp[2], a3 = sp[3]; v4u o0, o1;
      o0.x = pk2(a0[0], a0[1]); o0.y = pk2(a0[2], a0[3]); o0.z = pk2(a1[0], a1[1]); o0.w = pk2(a1[2], a1[3]);
      o1.x = pk2(a2[0], a2[1]); o1.y = pk2(a2[2], a2[3]); o1.z = pk2(a3[0], a3[1]); o1.w = pk2(a3[2], a3[3]);
      LAS v4u* dst = (LAS v4u*)(SB + dkk * 136 + sg); dst[0] = o0; dst[1] = o1; }
    float qv[8], kv[8];
#pragma unroll
    for (int tt = 0; tt < 8; ++tt) { const GAS bf16* pr = (const GAS bf16*)F.PROJ + (size_t)(r0 + 8 * w + tt) * LDP + h * DK + d; qv[tt] = bf2f(pr[PQ]); kv[tt] = bf2f(pr[PK]); }
    GLA_LOAD_GATEW();
    __syncthreads();
    float cs[8], run = 0.f;
#pragma unroll
    for (int tt = 0; tt < 8; ++tt) { const LAS float* gl = glr_s + (8 * w + tt) * 16; float z = bg;
#pragma unroll
        for (int r = 0; r < 16; ++r) z += gl[r] * wg[r];
        run += logsig(z) * (1.f / 16.f); cs[tt] = run; }
    wtot[w * 64 + d] = run;
    __syncthreads();
    float off = 0.f;
#pragma unroll
    for (int w2 = 0; w2 < 8; ++w2) { const float x = wtot[w2 * 64 + d]; if (w2 < w) off += x; }
#pragma unroll
    for (int tt = 0; tt < 8; ++tt) { const float bt = off + cs[tt]; qt[(8 * w + tt) * 72 + d] = (bf16)f2bf(qv[tt] * __expf(bt)); kt[(8 * w + tt) * 72 + d] = (bf16)f2bf(kv[tt] * __expf(-bt)); }
    __syncthreads();
    { const int jb = w & 3, ih = w >> 2; f32x4 a2[2]; a2[0] = (f32x4){0.f, 0.f, 0.f, 0.f}; a2[1] = a2[0];
#pragma unroll
      for (int ks = 0; ks < 2; ++ks) { const bf16x8 xa = ldfrag(kt, 72, 16 * jb, 32 * ks, lane);
#pragma unroll
          for (int q = 0; q < 2; ++q) { const bf16x8 xb = ldfrag(qt, 72, 16 * (2 * ih + q), 32 * ks, lane); a2[q] = MFMA16(xa, xb, a2[q]); } }
#pragma unroll
      for (int q = 0; q < 2; ++q) { const int i = 16 * (2 * ih + q) + fr, j0 = 16 * jb + 4 * fq;
          const float v0 = (j0 <= i) ? a2[q][0] : 0.f, v1 = (j0 + 1 <= i) ? a2[q][1] : 0.f, v2 = (j0 + 2 <= i) ? a2[q][2] : 0.f, v3 = (j0 + 3 <= i) ? a2[q][3] : 0.f;
          v2u o; o.x = pk2(v0, v1); o.y = pk2(v2, v3); *(LAS v2u*)(Pm + i * 72 + j0) = o; } }
    __syncthreads();
    { const int ib = w & 3, dvh = w >> 2; f32x4 a4[4];
#pragma unroll
      for (int n = 0; n < 4; ++n) a4[n] = (f32x4){0.f, 0.f, 0.f, 0.f};
#pragma unroll
      for (int ks = 0; ks < 2; ++ks) { const bf16x8 xb = ldfrag(Pm, 72, 16 * ib, 32 * ks, lane);
#pragma unroll
          for (int n = 0; n < 4; ++n) { const bf16x8 xa = frag_gather(Vs, 136, 32 * ks, 16 * (4 * dvh + n), lane); a4[n] = MFMA16(xa, xb, a4[n]); } }
#pragma unroll
      for (int ks = 0; ks < 2; ++ks) { const bf16x8 xb = ldfrag(qt, 72, 16 * ib, 32 * ks, lane);
#pragma unroll
          for (int n = 0; n < 4; ++n) { const bf16x8 xa = frag_gather(SB, 136, 32 * ks, 16 * (4 * dvh + n), lane); a4[n] = MFMA16(xa, xb, a4[n]); } }
#pragma unroll
      for (int n = 0; n < 4; ++n) *(LAS f32x4*)(os + (16 * ib + fr) * 132 + 16 * (4 * dvh + n) + 4 * fq) = a4[n]; }
    __syncthreads();
    { const int t = tid >> 3, sg = (tid & 7) * 16; const LAS f32x4* op = (const LAS f32x4*)(os + t * 132 + sg);
      f32x4 o[4]; float ss = 0.f;
#pragma unroll
      for (int q = 0; q < 4; ++q) { o[q] = op[q]; ss += (o[q][0] * o[q][0] + o[q][1] * o[q][1]) + (o[q][2] * o[q][2] + o[q][3] * o[q][3]); }
      ss += __shfl_xor(ss, 1); ss += __shfl_xor(ss, 2); ss += __shfl_xor(ss, 4);
      const float rstd = 1.f / sqrtf(ss * (1.f / DV) + EPS);
      const GAS v4u* ogp = (const GAS v4u*)(F.PROJ + (size_t)(r0 + t) * LDP + POG + h * DV + sg); const v4u g0 = ogp[0], g1 = ogp[1];
      const unsigned gw_[8] = {g0.x, g0.y, g0.z, g0.w, g1.x, g1.y, g1.z, g1.w}; unsigned ow[8];
#pragma unroll
      for (int p = 0; p < 8; ++p) { const int e = 2 * p; const float y0 = o[e >> 2][e & 3] * rstd * F.g_on[sg + e] * silu(bflo(gw_[p])), y1 = o[(e + 1) >> 2][(e + 1) & 3] * rstd * F.g_on[sg + e + 1] * silu(bfhi(gw_[p])); ow[p] = pk2(y0, y1); }
      GAS v4u* mo = (GAS v4u*)(F.MIX + (size_t)(r0 + t) * D + h * DV + sg); mo[0] = (v4u){ow[0], ow[1], ow[2], ow[3]}; mo[1] = (v4u){ow[4], ow[5], ow[6], ow[7]}; }
    __syncthreads();
}


constexpr int SG_LD = 272;
template <class Epi>
__device__ __forceinline__ void sg_unit(Frame& F, const bf16* A, int lda, const bf16* Bt, int ldb, int K, const Epi& E) {
    LAS bf16* As = (LAS bf16*)F.lds; LAS bf16* Bs = As + 64 * SG_LD;
    const int tid = F.tid, lane = F.lane, w = F.wave, wm = w >> 1, wn = w & 1, fr = lane & 15, fq = lane >> 4;
    v4u ra[4], rb[4];
    const int srow = tid >> 5, sch = (tid & 31) * 8, soff0 = srow * SG_LD + sch;
    const GAS bf16* gA = (const GAS bf16*)A + (size_t)srow * lda + sch; const GAS bf16* gB = (const GAS bf16*)Bt + (size_t)srow * ldb + sch;
#pragma unroll
    for (int i = 0; i < 4; ++i) { ra[i] = *(const GAS v4u*)(gA + (size_t)(16 * i) * lda); rb[i] = *(const GAS v4u*)(gB + (size_t)(16 * i) * ldb); }
    f32x4 acc0 = (f32x4){0.f, 0.f, 0.f, 0.f}, acc1 = acc0;
    const int nst = K / 256;
    for (int st = 0; st < nst; ++st) {
#pragma unroll
        for (int i = 0; i < 4; ++i) { *(LAS v4u*)(As + soff0 + 16 * i * SG_LD) = ra[i]; *(LAS v4u*)(Bs + soff0 + 16 * i * SG_LD) = rb[i]; }
        __syncthreads();
        if (st + 1 < nst) {
#pragma unroll
            for (int i = 0; i < 4; ++i) { ra[i] = *(const GAS v4u*)(gA + (size_t)(16 * i) * lda + (st + 1) * 256); rb[i] = *(const GAS v4u*)(gB + (size_t)(16 * i) * ldb + (st + 1) * 256); } }
#pragma unroll
        for (int ks = 0; ks < 8; ++ks) { const bf16x8 a = ldfrag(As, SG_LD, 16 * wm, 32 * ks, lane), b0 = ldfrag(Bs, SG_LD, 32 * wn, 32 * ks, lane), b1 = ldfrag(Bs, SG_LD, 32 * wn + 16, 32 * ks, lane);
            acc0 = MFMA16(b0, a, acc0); acc1 = MFMA16(b1, a, acc1); }
        __syncthreads();
    }
    E(16 * wm + fr, 32 * wn + 4 * fq, acc0, acc1, fq);
}
struct SgWo {
    const float* xs; float* H1; bf16* H1B; float* rowss; int rbase, cbase;
    __device__ __forceinline__ void operator()(int r, int c, f32x4 v0, f32x4 v1, int fq) const {
        const int srow = rbase + r, row = NP + srow, col = cbase + c;
        const GAS f32x4* xr = (const GAS f32x4*)(xs + (size_t)srow * D + col); const f32x4 h0 = xr[0] + v0, h1 = xr[4] + v1;
        GAS f32x4* ho = (GAS f32x4*)(H1 + (size_t)row * D + col); ho[0] = h0; ho[4] = h1;
        GAS v2u* hb = (GAS v2u*)(H1B + (size_t)row * D + col); hb[0] = (v2u){pk2(h0[0], h0[1]), pk2(h0[2], h0[3])}; hb[4] = (v2u){pk2(h1[0], h1[1]), pk2(h1[2], h1[3])};
        float ss = (h0[0] * h0[0] + h0[1] * h0[1]) + (h0[2] * h0[2] + h0[3] * h0[3]) + (h1[0] * h1[0] + h1[1] * h1[1]) + (h1[2] * h1[2] + h1[3] * h1[3]);
        ss += __shfl_xor(ss, 16); ss += __shfl_xor(ss, 32);
        if (fq == 0) atomicAdd(rowss + row, ss);
    }
};
struct SgUp {
    bf16* ACT; const float* rowss; int rbase, cbase;
    __device__ __forceinline__ void operator()(int r, int c, f32x4 v0, f32x4 v1, int fq) const {
        const int row = NP + rbase + r, col = cbase + c;
        const float r2 = __builtin_amdgcn_rcpf(((const GAS float*)rowss)[row] * (1.0f / D) + EPS);
#pragma unroll
        for (int e = 0; e < 4; ++e) { const float a = fmaxf(v0[e], 0.f), b = fmaxf(v1[e], 0.f); v0[e] = a * a * r2; v1[e] = b * b * r2; }
        GAS v2u* ao = (GAS v2u*)(ACT + (size_t)row * FF + col); ao[0] = (v2u){pk2(v0[0], v0[1]), pk2(v0[2], v0[3])}; ao[4] = (v2u){pk2(v1[0], v1[1]), pk2(v1[2], v1[3])};
    }
};
struct SgDown {
    const float* H; float* Ho; int rbase, cbase;
    __device__ __forceinline__ void operator()(int r, int c, f32x4 v0, f32x4 v1, int fq) const {
        const int row = NP + rbase + r, col = cbase + c;
        const GAS f32x4* hi = (const GAS f32x4*)(H + (size_t)row * D + col); GAS f32x4* ho = (GAS f32x4*)(Ho + (size_t)row * D + col);
        const f32x4 a = hi[0] + v0, b = hi[4] + v1; ho[0] = a; ho[4] = b;
    }
};

__device__ __forceinline__ void final_norm(Frame& F, float* dst, int omask) {
    const int gw = F.vcu * NWAVES + F.wave, NGW = F.G * NWAVES;
    f32x4 gv[4];
#pragma unroll
    for (int j = 0; j < 4; ++j) gv[j] = ((const GAS f32x4*)F.g_fin)[F.lane + 64 * j];
    for (int m = gw; m < M; m += NGW) { GAS f32x4* xr = (GAS f32x4*)((GAS float*)F.out + OUT_Y + (size_t)m * D) + F.lane;
        f32x4 v[4]; float s = 0.f;
#pragma unroll
        for (int j = 0; j < 4; ++j) { v[j] = xr[64 * j]; s += (v[j].x * v[j].x + v[j].y * v[j].y) + (v[j].z * v[j].z + v[j].w * v[j].w); }
        const float rstd = 1.f / sqrtf(wave_sum(s) * (1.f / D) + EPS);
        GAS f32x4* xo = (GAS f32x4*)((GAS float*)dst + (size_t)(m & omask) * D) + F.lane;
#pragma unroll
        for (int j = 0; j < 4; ++j) xo[64 * j] = v[j] * rstd * gv[j]; }
}

struct Args { const float* in[17]; float* out; unsigned char* ws; int ph_lo, ph_hi; };
__global__ void __launch_bounds__(NWAVES * 64, 2) mega_fwd(Args args) {
    extern __shared__ __attribute__((aligned(16))) unsigned char lds[];
    Frame F;
    F.lds = (LAS unsigned char*)lds;
    F.MISC = (volatile LAS unsigned*)(F.lds + MISC_OFF);
    F.tid = threadIdx.x; F.lane = F.tid & 63; F.wave = __builtin_amdgcn_readfirstlane(F.tid >> 6);
    F.G = gridDim.x; { const int bx = blockIdx.x; F.vcu = (F.G % 8 == 0) ? (bx % 8) * (F.G / 8) + bx / 8 : bx; }
    unsigned char* ws = args.ws;
    F.ctl = (gu32*)(ws + WS_CTL);
    F.xp = args.in[0]; F.xs = args.in[1]; F.state = args.in[2]; F.g_mix = args.in[3]; F.w_in = args.in[4]; F.w_gu = args.in[5]; F.b_gate = args.in[6]; F.g_on = args.in[7];
    F.ln_g = args.in[8]; F.ln_b = args.in[9]; F.w_s = args.in[10]; F.b_s = args.in[11]; F.w_o = args.in[12]; F.g_ffn = args.in[13]; F.w_up = args.in[14]; F.w_dn = args.in[15]; F.g_fin = args.in[16];
    F.out = args.out;
    F.WinT = (bf16*)(ws + WS_WIN); F.WoT = (bf16*)(ws + WS_WO); F.WupT = (bf16*)(ws + WS_WUP); F.WdnT = (bf16*)(ws + WS_WDN);
    F.XN = (bf16*)(ws + WS_XN); F.PROJ = (bf16*)(ws + WS_PROJ); F.MIX = (bf16*)(ws + WS_MIX); F.ACT = (bf16*)(ws + WS_ACT);
    F.GLR = (float*)(ws + WS_GLR); F.DEC = (float*)(ws + WS_DEC); F.U = (float*)(ws + WS_U); F.US = (float*)(ws + WS_US); F.RSS = (float*)(ws + WS_RSS);
    for (int u = F.tid; u < (LDS_BYTES - LDSCTL_OFF) / 4; u += NWAVES * 64) ((LAS unsigned*)(F.lds + LDSCTL_OFF))[u] = 0u;
    __syncthreads();
    XcdBarrier bar; bar.bar = (unsigned*)(F.ctl + CW_BAR); bar.x = 0; bar.st = nullptr;
    if (N_LAUNCHES != PER_PHASE) bar = xcd_barrier_post((unsigned*)(F.ctl + CW_BAR), F.MISC + 8);
#define GRID_BAR(seam) do { if (N_LAUNCHES == PER_PHASE) { if (F.tid == 0) __hip_atomic_store(F.ctl + CW_TMO, 0xBADBA0u | (unsigned)(seam), RLX_AGENT); } else { xcd_barrier(bar); } } while (0)
    const int lo = args.ph_lo, hi = args.ph_hi;
#define IN(k) (lo <= (k) && (k) < hi)
#define BOTH(k) (IN(k) && IN((k) + 1))
#define REPS(k) ((PROBE_REP == (k)) ? 2 : 1)
    constexpr int NPASS = (PROBE_REP == 200) ? 2 : 1;

    for (int pass = 0; pass < NPASS; ++pass) {
#define LASTPASS (pass == NPASS - 1)
    if (IN(0)) { for (int rep = 0; rep < REPS(0); ++rep) p0_prologue(F); if (BOTH(0)) GRID_BAR(0); }
    if (IN(1)) for (int rep = 0; rep < REPS(1); ++rep) {
        pg8::Gemm g{F.XN, F.WinT, M, NPROJ, D}; pg8::StaticOrder S; S.init(M, NPROJ, F.G, (int)blockIdx.x);
        pg8::EpiProj E{F.PROJ, F.GLR};
        pg8::gemm_phase<pg8::EpiProj, pg8::StaticOrder, PG8_ALIGN, PG8_SP2>(F.lds + RING_OFF, g, S, E);
        if (BOTH(1)) GRID_BAR(1);
    }
    if (IN(2)) for (int rep = 0; rep < REPS(2); ++rep) {
        for (int it = F.vcu; it < NITEM_GLA; it += F.G) gla_local_item(F, it);
        for (int it = F.vcu; it < DECB * NH; it += F.G) gla_sample_item(F, it);
        for (int it = F.vcu; it < DECB; it += F.G) cmlp_sample_item(F, it);
        if (BOTH(2)) GRID_BAR(2);
    }
    if (IN(3)) for (int rep = 0; rep < REPS(3); ++rep) {
        gla_scan(F);
        for (int it = F.vcu; it < NB * 16 * 2; it += F.G) cmlp_prompt_item(F, it);
        if (BOTH(3)) GRID_BAR(3);
    }
    if (IN(4)) for (int rep = 0; rep < REPS(4); ++rep) {
        for (int it = F.vcu; it < NITEM_GLA; it += F.G) gla_out_item(F, it);
        if (BOTH(4)) GRID_BAR(4);
    }
    if (IN(5)) for (int rep = 0; rep < REPS(5); ++rep) {
        pg8::Gemm g{F.MIX, F.WoT, NP, D, D}; pg8::StaticOrder S; S.init(NP, D, F.G, (int)blockIdx.x);
        pg8::EpiWo E{F.xp, F.xs, F.out + OUT_Y, F.XN, (LASTPASS && rep == REPS(5) - 1) ? F.RSS : (float*)(args.ws + WS_DUMMY)};
        pg8::gemm_phase<pg8::EpiWo, pg8::StaticOrder, PG8_ALIGN, PG8_SP2>(F.lds + RING_OFF, g, S, E);
        for (int u = F.vcu; u < 256; u += F.G) { const int rs = u >> 4, cs = u & 15; SgWo Es{F.xs, F.out + OUT_Y, F.XN, E.rowss, 64 * rs, 64 * cs};
            sg_unit(F, F.MIX + (size_t)(NP + 64 * rs) * D, D, F.WoT + (size_t)(64 * cs) * D, D, D, Es); }
        if (BOTH(5)) GRID_BAR(5);
    }
    if (IN(6)) for (int rep = 0; rep < REPS(6); ++rep) {
        pg8::Gemm g{F.XN, F.WupT, NP, FF, D}; pg8::StaticOrder S; S.init(NP, FF, F.G, (int)blockIdx.x);
        pg8::EpiUp E{F.ACT, F.RSS};
        pg8::gemm_phase<pg8::EpiUp, pg8::StaticOrder, PG8_ALIGN, PG8_SP2>(F.lds + RING_OFF, g, S, E);
        for (int u = F.vcu; u < 1024; u += F.G) { const int rs = u >> 6, cs = u & 63; SgUp Es{F.ACT, F.RSS, 64 * rs, 64 * cs};
            sg_unit(F, F.XN + (size_t)(NP + 64 * rs) * D, D, F.WupT + (size_t)(64 * cs) * D, D, D, Es); }
        if (BOTH(6)) GRID_BAR(6);
    }
    if (IN(7)) for (int rep = 0; rep < REPS(7); ++rep) {
        pg8::Gemm g{F.ACT, F.WdnT, NP, D, FF}; pg8::StaticOrder S; S.init(NP, D, F.G, (int)blockIdx.x);
        pg8::EpiDown E{F.out + OUT_Y, (LASTPASS && rep == REPS(7) - 1) ? F.out + OUT_Y : (float*)(args.ws + WS_XN), (LASTPASS && rep == REPS(7) - 1) ? 0x7fffffff : 8191};
        pg8::gemm_phase<pg8::EpiDown, pg8::StaticOrder, PG8_ALIGN, PG8_SP2>(F.lds + RING_OFF, g, S, E);
        for (int u = F.vcu; u < 256; u += F.G) { const int rs = u >> 4, cs = u & 15; SgDown Es{F.out + OUT_Y, E.omask == 8191 ? (float*)(args.ws + WS_XN) : F.out + OUT_Y, E.omask == 8191 ? -NP : 64 * rs, 64 * cs};
            sg_unit(F, F.ACT + (size_t)(NP + 64 * rs) * FF, FF, F.WdnT + (size_t)(64 * cs) * FF, FF, FF, Es); }
        if (BOTH(7)) GRID_BAR(7);
        if (PROBE_REP == 100 && rep == 0) { for (int q = 0; q < 8; ++q) GRID_BAR(7); }
    }
    if (IN(8)) for (int rep = 0; rep < REPS(8); ++rep) { const bool real = LASTPASS && rep == REPS(8) - 1; final_norm(F, real ? F.out + OUT_Y : (float*)(args.ws + WS_XN), real ? 0x7fffffff : 8191); }
    if (!LASTPASS) GRID_BAR(8);
    }
#undef IN
#undef BOTH
}

extern "C" void kernel_launch(void* const* d_in, const int* in_sizes, int n_in, void* d_out, int out_size, void* d_ws, size_t ws_size, hipStream_t stream) {
    static int grid = 0;
    if (grid == 0) {
        if (n_in != 17 || ws_size < WS_END) { fprintf(stderr, "kernel_launch: built for 17 inputs and >= %zu bytes of workspace; got n_in %d, ws %zu; nothing launched\n", (size_t)WS_END, n_in, ws_size); grid = -1; return; }
        int dev = 0, cus = 0, per_cu = 0;
        if (hipGetDevice(&dev) != hipSuccess || hipDeviceGetAttribute(&cus, hipDeviceAttributeMultiprocessorCount, dev) != hipSuccess) { fprintf(stderr, "kernel_launch: hipGetDevice / hipDeviceGetAttribute failed\n"); grid = -1; return; }
        if (hipFuncSetAttribute((const void*)mega_fwd, hipFuncAttributeMaxDynamicSharedMemorySize, LDS_BYTES) != hipSuccess) { fprintf(stderr, "kernel_launch: hipFuncSetAttribute failed\n"); grid = -1; return; }
        if (hipOccupancyMaxActiveBlocksPerMultiprocessor(&per_cu, (const void*)mega_fwd, NWAVES * 64, LDS_BYTES) != hipSuccess || per_cu < 1)
            fprintf(stderr, "kernel_launch: note: occupancy query reports %d workgroups per CU\n", per_cu);
        (void)hipGetLastError();
        grid = cus;
    }
    if (grid < 0) return;
    if (hipMemsetAsync((char*)d_ws + WS_CTL, 0, CTL_ZERO_BYTES, stream) != hipSuccess) { fprintf(stderr, "kernel_launch: hipMemsetAsync failed\n"); return; }
    Args a{};
    for (int i = 0; i < 17; ++i) a.in[i] = (const float*)d_in[i];
    a.out = (float*)d_out; a.ws = (unsigned char*)d_ws;
    for (int li = 0; li < N_LAUNCHES; ++li) {
        a.ph_lo = (N_LAUNCHES == PER_PHASE) ? li : 0; a.ph_hi = (N_LAUNCHES == PER_PHASE) ? li + 1 : PER_PHASE;
        hipLaunchKernelGGL(mega_fwd, dim3(grid), dim3(NWAVES * 64), LDS_BYTES, stream, a);
        const hipError_t le = hipPeekAtLastError();
        if (le != hipSuccess) { fprintf(stderr, "kernel_launch: launch %d failed: %s\n", li, hipGetErrorName(le)); break; }
    }
}
```
